# Optimizing an MI355X kernel written in HIP

```python
import math
import jax, jax.numpy as jnp
from jax import lax
import numpy as np

D_MODEL = 1024
BATCH = 8
SEQ = 4096
DEPTH = 1

RET_HEADS = 4
RET_QK_DIM = 64
RET_V_DIM = 128
RET_WIDTH = RET_HEADS * RET_V_DIM
RET_CHUNK = 128
ROPE_BASE = 10000.0
CONV_CH = 512
CONV_K = 31
IN_SPLITS = (RET_HEADS * RET_QK_DIM, RET_HEADS * RET_QK_DIM, RET_WIDTH, RET_WIDTH,
             CONV_CH, CONV_CH, D_MODEL, D_MODEL)
IN_COLS = sum(IN_SPLITS)
PEER_HEADS = 8
PEER_QDIM = 256
PEER_HALF = PEER_QDIM // 2
N_KEYS = 128
N_EXPERTS = N_KEYS * N_KEYS
PEER_TOPK = 16
TOKEN_BLOCK = 128

RMS_EPS = 1e-6
LN_EPS = 1e-5

kernel_name = "hybrid_retention_conformer_peer"


def rms_norm(x, g):
    xf = x.astype(jnp.float32)
    y = xf * lax.rsqrt(jnp.mean(xf * xf, axis=-1, keepdims=True) + RMS_EPS)
    return (y * g.astype(jnp.float32)).astype(x.dtype)


def layer_norm(x, g, b):
    xf = x.astype(jnp.float32)
    mu = jnp.mean(xf, axis=-1, keepdims=True)
    var = jnp.mean(jnp.square(xf - mu), axis=-1, keepdims=True)
    y = (xf - mu) * lax.rsqrt(var + LN_EPS)
    return (y * g.astype(jnp.float32) + b.astype(jnp.float32)).astype(x.dtype)


def rotary(t):
    s, d = t.shape[1], t.shape[-1]
    half = d // 2
    inv = 1.0 / (ROPE_BASE ** (jnp.arange(half, dtype=jnp.float32) / half))
    ang = jnp.arange(s, dtype=jnp.float32)[:, None] * inv[None, :]
    cos = jnp.cos(ang)[None, :, None, :]
    sin = jnp.sin(ang)[None, :, None, :]
    tf = t.astype(jnp.float32)
    t1, t2 = tf[..., :half], tf[..., half:]
    return jnp.concatenate([t1 * cos - t2 * sin, t1 * sin + t2 * cos], axis=-1)


def chunkwise_retention(q, k, v):
    bsz, s, h, dk = q.shape
    dv = v.shape[-1]
    n_chunks = s // RET_CHUNK
    c = RET_CHUNK
    log_gamma = jnp.log1p(-(2.0 ** (-5.0 - jnp.arange(h, dtype=jnp.float32))))
    n_idx = jnp.arange(c, dtype=jnp.float32)
    diff = n_idx[:, None] - n_idx[None, :]
    intra = jnp.where(diff[None] >= 0, jnp.exp(log_gamma[:, None, None] * jnp.maximum(diff, 0.0)[None]), 0.0)
    q_decay = jnp.exp(log_gamma[:, None] * (n_idx + 1.0)[None])
    k_decay = jnp.exp(log_gamma[:, None] * (c - 1.0 - n_idx)[None])
    chunk_decay = jnp.exp(log_gamma * c)

    def to_chunks(t):
        return t.reshape(bsz, n_chunks, c, h, t.shape[-1]).transpose(1, 0, 3, 2, 4)

    qc, kc, vc = to_chunks(q), to_chunks(k), to_chunks(v)

    def step(state, inp):
        qi, ki, vi = inp
        scores = jnp.einsum('bhnd,bhmd->bhnm', qi, ki) * intra[None]
        inner = jnp.einsum('bhnm,bhme->bhne', scores, vi)
        cross = jnp.einsum('bhnd,bhde->bhne', qi, state) * q_decay[None, :, :, None]
        new_state = state * chunk_decay[None, :, None, None] + jnp.einsum(
            'bhmd,bhme->bhde', ki * k_decay[None, :, :, None], vi)
        return new_state, inner + cross

    state0 = jnp.zeros((bsz, h, dk, dv), jnp.float32)
    _, out = lax.scan(step, state0, (qc, kc, vc))
    return out.transpose(1, 0, 3, 2, 4).reshape(bsz, s, h, dv)


def retention_branch(q, k, v, g, gn_g, w_proj):
    bsz, s, _ = q.shape
    dt = q.dtype
    q = rotary(q.reshape(bsz, s, RET_HEADS, RET_QK_DIM))
    k = rotary(k.reshape(bsz, s, RET_HEADS, RET_QK_DIM)) * (RET_QK_DIM ** -0.5)
    v = v.reshape(bsz, s, RET_HEADS, RET_V_DIM).astype(jnp.float32)
    o = chunkwise_retention(q, k, v)
    mu = jnp.mean(o, axis=-1, keepdims=True)
    var = jnp.mean(jnp.square(o - mu), axis=-1, keepdims=True)
    o = (o - mu) * lax.rsqrt(var + LN_EPS) * gn_g.astype(jnp.float32)[None, None]
    o = o.reshape(bsz, s, RET_WIDTH).astype(dt)
    return (jax.nn.silu(g) * o) @ w_proj


def conv_branch(u_val, u_gate, dw_w, dw_b, ln_g, ln_b, w_proj, b_proj):
    c = u_val * jax.nn.sigmoid(u_gate)
    c = lax.conv_general_dilated(
        c, dw_w[:, None, :].astype(c.dtype), window_strides=(1,),
        padding=[(CONV_K - 1, 0)], dimension_numbers=('NWC', 'WIO', 'NWC'),
        feature_group_count=CONV_CH) + dw_b
    c = jax.nn.silu(layer_norm(c, ln_g, ln_b))
    return c @ w_proj + b_proj


def peer_ffn(hn, w_query, sub_keys, u_tab, v_tab):
    bsz, s, d = hn.shape
    t = bsz * s
    hf = hn.reshape(t, d)
    q = (hf @ w_query).reshape(t, PEER_HEADS, 2, PEER_HALF)
    scores = jnp.einsum('thpd,hpnd->thpn', q, sub_keys).astype(jnp.float32)
    s1, i1 = lax.top_k(scores[:, :, 0], PEER_TOPK)
    s2, i2 = lax.top_k(scores[:, :, 1], PEER_TOPK)
    cand = (s1[..., :, None] + s2[..., None, :]).reshape(t, PEER_HEADS, PEER_TOPK * PEER_TOPK)
    best, pos = lax.top_k(cand, PEER_TOPK)
    e1 = jnp.take_along_axis(i1, pos // PEER_TOPK, axis=-1)
    e2 = jnp.take_along_axis(i2, pos % PEER_TOPK, axis=-1)
    experts = (e1 * N_KEYS + e2).reshape(t, PEER_HEADS * PEER_TOPK)
    gates = jax.nn.softmax(best, axis=-1).reshape(t, PEER_HEADS * PEER_TOPK).astype(hn.dtype)

    nb = t // TOKEN_BLOCK
    kk = PEER_HEADS * PEER_TOPK

    def apply_block(inp):
        hb, eb, gb = inp
        u = u_tab[eb]
        a = jax.nn.gelu(jnp.einsum('td,tkd->tk', hb, u), approximate=False) * gb
        return jnp.einsum('tk,tkd->td', a, v_tab[eb])

    out = lax.map(apply_block, (hf.reshape(nb, TOKEN_BLOCK, d),
                                experts.reshape(nb, TOKEN_BLOCK, kk),
                                gates.reshape(nb, TOKEN_BLOCK, kk)))
    return out.reshape(bsz, s, d)


def setup_inputs(seed: int = 0) -> dict:
    key = jax.random.key(seed)
    ks = jax.random.split(key, 20)
    nrm = jax.random.normal
    f32 = jnp.float32
    return {
        "x": nrm(ks[0], (BATCH, SEQ, D_MODEL), f32),
        "rms_mix_g": 1.0 + 0.02 * nrm(ks[1], (DEPTH, D_MODEL), f32),
        "w_in": nrm(ks[2], (DEPTH, D_MODEL, IN_COLS), f32) * D_MODEL ** -0.5,
        "ret_gn_g": 1.0 + 0.02 * nrm(ks[3], (DEPTH, RET_HEADS, RET_V_DIM), f32),
        "conv_dw_w": nrm(ks[4], (DEPTH, CONV_K, CONV_CH), f32) * CONV_K ** -0.5,
        "conv_dw_b": 0.02 * nrm(ks[5], (DEPTH, CONV_CH), f32),
        "conv_ln_g": 1.0 + 0.02 * nrm(ks[6], (DEPTH, CONV_CH), f32),
        "conv_ln_b": 0.02 * nrm(ks[7], (DEPTH, CONV_CH), f32),
        "w_ret_proj": nrm(ks[8], (DEPTH, RET_WIDTH, D_MODEL), f32) * RET_WIDTH ** -0.5,
        "w_conv_proj": nrm(ks[9], (DEPTH, CONV_CH, D_MODEL), f32) * CONV_CH ** -0.5,
        "b_conv_proj": 0.02 * nrm(ks[10], (DEPTH, D_MODEL), f32),
        "w_out": nrm(ks[11], (DEPTH, D_MODEL, D_MODEL), f32) * D_MODEL ** -0.5,
        "rms_ffn_g": 1.0 + 0.02 * nrm(ks[12], (DEPTH, D_MODEL), f32),
        "w_query": nrm(ks[13], (DEPTH, D_MODEL, PEER_HEADS * PEER_QDIM), f32) * D_MODEL ** -0.5,
        "peer_sub_keys": nrm(ks[14], (DEPTH, PEER_HEADS, 2, N_KEYS, PEER_HALF), f32) * PEER_HALF ** -0.5,
        "peer_u": nrm(ks[15], (DEPTH, N_EXPERTS, D_MODEL), f32) * D_MODEL ** -0.5,
        "peer_v": nrm(ks[16], (DEPTH, N_EXPERTS, D_MODEL), f32) * 0.5,
        "rms_final_g": 1.0 + 0.02 * nrm(ks[17], (D_MODEL,), f32),
    }


def reference(x, rms_mix_g, w_in, ret_gn_g, conv_dw_w, conv_dw_b, conv_ln_g, conv_ln_b,
              w_ret_proj, w_conv_proj, b_conv_proj, w_out, rms_ffn_g, w_query,
              peer_sub_keys, peer_u, peer_v, rms_final_g):
    split_points = list(np.cumsum(IN_SPLITS)[:-1])
    for l in range(DEPTH):
        h = rms_norm(x, rms_mix_g[l])
        proj = h @ w_in[l]
        q, k, v, g_ret, u_val, u_gate, gate_a, gate_b = jnp.split(proj, split_points, axis=-1)
        a = retention_branch(q, k, v, g_ret, ret_gn_g[l], w_ret_proj[l])
        b = conv_branch(u_val, u_gate, conv_dw_w[l], conv_dw_b[l], conv_ln_g[l], conv_ln_b[l],
                        w_conv_proj[l], b_conv_proj[l])
        mixed = jax.nn.sigmoid(gate_a) * a + jax.nn.sigmoid(gate_b) * b
        x = x + mixed @ w_out[l]
        hn = rms_norm(x, rms_ffn_g[l])
        x = x + peer_ffn(hn, w_query[l], peer_sub_keys[l], peer_u[l], peer_v[l])
    return rms_norm(x, rms_final_g)
```

```cpp
#include <hip/hip_runtime.h>
#include <cstdio>
#include <cstdint>
#ifndef P1_FP8
#define P1_FP8 true
#endif
constexpr int P1_SA = 3, P1_SB = 6, P1_NB = 2048;
#ifndef GATE_FP8
#define GATE_FP8 true
#endif
#ifndef P6_FP8
#define P6_FP8 false
#endif
constexpr int P6_SA = 2, P6_SB = 6;
__device__ __forceinline__ int mk_lane() { int l; asm volatile("v_mbcnt_lo_u32_b32 %0, -1, 0\n\tv_mbcnt_hi_u32_b32 %0, -1, %0" : "=v"(l)); return l; }
namespace pg8 {
#define PG8_LAS __attribute__((address_space(3)))
typedef unsigned short bf16_t;
typedef short bf16x8 __attribute__((ext_vector_type(8)));
typedef int v4i_t __attribute__((ext_vector_type(4)));
typedef int v8i_t __attribute__((ext_vector_type(8)));
typedef float f32x4 __attribute__((ext_vector_type(4)));
typedef unsigned u32x4 __attribute__((ext_vector_type(4)));
typedef unsigned u32x2 __attribute__((ext_vector_type(2)));
constexpr int BM = 256, BK = 64, HALF = 128, HTB = HALF * BK * 2  , STAGE_BYTES = 8 * HTB, NXCD = 8, WGM = 8;

__host__ __device__ __forceinline__ int lds_byte(int r, int c) { const int st = (r >> 4) * 2 + (c >> 5), rr = r & 15, cc = c & 31, ob = rr * 64 + cc * 2; return st * 1024 + (ob ^ (((ob >> 9) & 1) << 5)); }
__host__ __device__ __forceinline__ void stage_rc(int b, int& R, int& C) { const int st = b / 1024, sb = b % 1024, swz = sb ^ (((sb >> 9) & 1) << 5); R = (st >> 1) * 16 + swz / 64; C = (st & 1) * 32 + (swz % 64) / 2; }
__host__ __device__ __forceinline__ int perm32(int rho) { const int n = rho >> 4, i = rho & 15; return 8 * (i >> 2) + 4 * n + (i & 3); }

struct Unit { int pm, pn, br; };
struct Gemm { const bf16_t* A; const bf16_t* Bt; int M, N, K; const bf16_t* A2; const bf16_t* Bt2; };

struct StaticOrder {
    int nM, nN, nwg, G, c;
    __host__ __device__ void init(int M, int N, int G_, int c_) { nM = M / BM; nN = N / BM; nwg = nM * nN; G = G_; c = c_; }
    __host__ __device__ bool next(int i, Unit& u) const {
        const long L = (long)i * G + c; if (L >= nwg) return false;
        int wgid = (int)L; { const int q = nwg / NXCD, r = nwg % NXCD, xcd = wgid % NXCD, off = wgid / NXCD; wgid = (xcd < r ? xcd * (q + 1) : r * (q + 1) + (xcd - r) * q) + off; }
        const int nig = WGM * nN, gid = wgid / nig, fm = gid * WGM, gsz = (nM - fm) < WGM ? (nM - fm) : WGM;
        u.pm = fm + ((wgid % nig) % gsz); u.pn = (wgid % nig) / gsz; u.br = 0; return true;
    }
    __device__ __forceinline__ void a_ready(const Unit&) const {}
    __device__ __forceinline__ void done(const Unit&) const {}
};
struct DualOrder : StaticOrder {
    __host__ __device__ bool next(int i, Unit& u) const { if (!StaticOrder::next(i >> 1, u)) return false; u.br = i & 1; return true; }
};

__device__ __forceinline__ unsigned cvt_pk_bf16(float lo, float hi) { typedef __bf16 bf16x2_t __attribute__((ext_vector_type(2))); bf16x2_t r; r.x = (__bf16)lo; r.y = (__bf16)hi; return __builtin_bit_cast(unsigned, r); }

__device__ __forceinline__ float bf_lo(unsigned w) { return __builtin_bit_cast(float, w << 16); }
__device__ __forceinline__ float bf_hi(unsigned w) { return __builtin_bit_cast(float, w & 0xffff0000u); }
__device__ __forceinline__ float sigmoidf_fast(float x) { return __builtin_amdgcn_rcpf(1.0f + __builtin_amdgcn_exp2f(-1.4426950408889634f * x)); }

struct EpiBf16Plain {
    static constexpr bool PERM = true, AFTER_DRAIN = false, CHAIN = false;
    bf16_t* O; int ldc;
    __device__ __forceinline__ void operator()(const f32x4 (&acc)[2][2][4][2], const Unit& u, int wr, int wc, int fr, int fq) const {
        const int row0 = u.pm * BM + wr * 64 + fr, col0 = u.pn * BM + wc * 32 + 8 * fq;
#pragma unroll
        for (int ai = 0; ai < 2; ++ai)
#pragma unroll
            for (int m = 0; m < 4; ++m) { bf16_t* rowp = O + (size_t)(row0 + ai * HALF + m * 16) * ldc + col0;
#pragma unroll
                for (int bj = 0; bj < 2; ++bj) { const f32x4 v0 = acc[ai][bj][m][0], v1 = acc[ai][bj][m][1];
                    u32x4 w; w.x = cvt_pk_bf16(v0[0], v0[1]); w.y = cvt_pk_bf16(v0[2], v0[3]); w.z = cvt_pk_bf16(v1[0], v1[1]); w.w = cvt_pk_bf16(v1[2], v1[3]);
                    *(u32x4*)(rowp + bj * HALF) = w; } }
    }
};
struct EpiF16Plain {
    static constexpr bool PERM = true, AFTER_DRAIN = false, CHAIN = false;
    unsigned short* O; int ldc;
    __device__ __forceinline__ static unsigned pkh(float a, float b) { typedef _Float16 h2 __attribute__((ext_vector_type(2))); h2 h; h.x = (_Float16)a; h.y = (_Float16)b; return __builtin_bit_cast(unsigned, h); }
    __device__ __forceinline__ void operator()(const f32x4 (&acc)[2][2][4][2], const Unit& u, int wr, int wc, int fr, int fq) const {
        const int row0 = u.pm * BM + wr * 64 + fr, col0 = u.pn * BM + wc * 32 + 8 * fq;
#pragma unroll
        for (int ai = 0; ai < 2; ++ai)
#pragma unroll
            for (int m = 0; m < 4; ++m) { unsigned short* rowp = O + (size_t)(row0 + ai * HALF + m * 16) * ldc + col0;
#pragma unroll
                for (int bj = 0; bj < 2; ++bj) { const f32x4 v0 = acc[ai][bj][m][0], v1 = acc[ai][bj][m][1];
                    u32x4 w; w.x = pkh(v0[0], v0[1]); w.y = pkh(v0[2], v0[3]); w.z = pkh(v1[0], v1[1]); w.w = pkh(v1[2], v1[3]);
                    *(u32x4*)(rowp + bj * HALF) = w; } }
    }
};
struct EpiGateA {
    static constexpr bool PERM = true, AFTER_DRAIN = false, CHAIN = false;
    bf16_t* T; int ldc; const bf16_t* G; int ldg;
    __device__ __forceinline__ void operator()(const f32x4 (&acc)[2][2][4][2], const Unit& u, int wr, int wc, int fr, int fq) const {
        const int row0 = u.pm * BM + wr * 64 + fr, col0 = u.pn * BM + wc * 32 + 8 * fq;
#pragma unroll
        for (int ai = 0; ai < 2; ++ai)
#pragma unroll
            for (int m = 0; m < 4; ++m) { const int row = row0 + ai * HALF + m * 16; bf16_t* rowp = T + (size_t)row * ldc + col0; const bf16_t* gp = G + (size_t)row * ldg + col0;
#pragma unroll
                for (int bj = 0; bj < 2; ++bj) { const f32x4 v0 = acc[ai][bj][m][0], v1 = acc[ai][bj][m][1];
                    const u32x4 g = *(const u32x4*)(gp + bj * HALF);
                    u32x4 w;
                    w.x = cvt_pk_bf16(v0[0] * sigmoidf_fast(bf_lo(g.x)), v0[1] * sigmoidf_fast(bf_hi(g.x)));
                    w.y = cvt_pk_bf16(v0[2] * sigmoidf_fast(bf_lo(g.y)), v0[3] * sigmoidf_fast(bf_hi(g.y)));
                    w.z = cvt_pk_bf16(v1[0] * sigmoidf_fast(bf_lo(g.z)), v1[1] * sigmoidf_fast(bf_hi(g.z)));
                    w.w = cvt_pk_bf16(v1[2] * sigmoidf_fast(bf_lo(g.w)), v1[3] * sigmoidf_fast(bf_hi(g.w)));
                    *(u32x4*)(rowp + bj * HALF) = w; } }
    }
};
struct EpiGateB {
    static constexpr bool PERM = true, AFTER_DRAIN = false, CHAIN = false;
    bf16_t* T; int ldc; const bf16_t* G; int ldg; const float* bias;
    __device__ __forceinline__ void operator()(const f32x4 (&acc)[2][2][4][2], const Unit& u, int wr, int wc, int fr, int fq) const {
        const int row0 = u.pm * BM + wr * 64 + fr, col0 = u.pn * BM + wc * 32 + 8 * fq;
        f32x4 bv[2][2];
#pragma unroll
        for (int bj = 0; bj < 2; ++bj)
#pragma unroll
            for (int n = 0; n < 2; ++n) bv[bj][n] = *(const f32x4*)(bias + col0 + bj * HALF + 4 * n);
#pragma unroll
        for (int ai = 0; ai < 2; ++ai)
#pragma unroll
            for (int m = 0; m < 4; ++m) { const int row = row0 + ai * HALF + m * 16; bf16_t* rowp = T + (size_t)row * ldc + col0; const bf16_t* gp = G + (size_t)row * ldg + col0;
#pragma unroll
                for (int bj = 0; bj < 2; ++bj) { const f32x4 v0 = acc[ai][bj][m][0] + bv[bj][0], v1 = acc[ai][bj][m][1] + bv[bj][1];
                    const u32x4 g = *(const u32x4*)(gp + bj * HALF);
                    const u32x4 t = *(const u32x4*)(rowp + bj * HALF);
                    u32x4 w;
                    w.x = cvt_pk_bf16(bf_lo(t.x) + v0[0] * sigmoidf_fast(bf_lo(g.x)), bf_hi(t.x) + v0[1] * sigmoidf_fast(bf_hi(g.x)));
                    w.y = cvt_pk_bf16(bf_lo(t.y) + v0[2] * sigmoidf_fast(bf_lo(g.y)), bf_hi(t.y) + v0[3] * sigmoidf_fast(bf_hi(g.y)));
                    w.z = cvt_pk_bf16(bf_lo(t.z) + v1[0] * sigmoidf_fast(bf_lo(g.z)), bf_hi(t.z) + v1[1] * sigmoidf_fast(bf_hi(g.z)));
                    w.w = cvt_pk_bf16(bf_lo(t.w) + v1[2] * sigmoidf_fast(bf_lo(g.w)), bf_hi(t.w) + v1[3] * sigmoidf_fast(bf_hi(g.w)));
                    *(u32x4*)(rowp + bj * HALF) = w; } }
    }
};
struct EpiResF32 {
    static constexpr bool PERM = false, AFTER_DRAIN = false, CHAIN = false;
    float* C; int ldc; const float* R;
    __device__ __forceinline__ void operator()(const f32x4 (&acc)[2][2][4][2], const Unit& u, int wr, int wc, int fr, int fq) const {
        const int row0 = u.pm * BM + wr * 64 + fr, col0 = u.pn * BM + wc * 32 + 4 * fq;
#pragma unroll
        for (int ai = 0; ai < 2; ++ai)
#pragma unroll
            for (int m = 0; m < 4; ++m) { const size_t off = (size_t)(row0 + ai * HALF + m * 16) * ldc + col0;
#pragma unroll
                for (int bj = 0; bj < 2; ++bj)
#pragma unroll
                    for (int n = 0; n < 2; ++n) *(f32x4*)(C + off + bj * HALF + n * 16) = acc[ai][bj][m][n] + *(const f32x4*)(R + off + bj * HALF + n * 16); }
    }
};
struct EpiResBf16SS {
    static constexpr bool PERM = true, AFTER_DRAIN = false, CHAIN = false;
    bf16_t* O; int ldc; const float* R; float* SS;
    __device__ __forceinline__ void operator()(const f32x4 (&acc)[2][2][4][2], const Unit& u, int wr, int wc, int fr, int fq) const {
        int upm = u.pm, upn = u.pn; asm volatile("" : "+s"(upm), "+s"(upn)); const int lnow = mk_lane(), frv = lnow & 15, fqv = lnow >> 4;
        const int row0 = upm * BM + wr * 64 + frv, col0 = upn * BM + wc * 32 + 8 * fqv;
#pragma unroll
        for (int ai = 0; ai < 2; ++ai)
#pragma unroll
            for (int m = 0; m < 4; ++m) { const int row = row0 + ai * HALF + m * 16; const size_t off = (size_t)row * ldc + col0; float ssq = 0.f;
#pragma unroll
                for (int bj = 0; bj < 2; ++bj) { const f32x4 v0 = acc[ai][bj][m][0] + *(const f32x4*)(R + off + bj * HALF), v1 = acc[ai][bj][m][1] + *(const f32x4*)(R + off + bj * HALF + 4);
                    ssq += (v0[0] * v0[0] + v0[1] * v0[1]) + (v0[2] * v0[2] + v0[3] * v0[3]) + (v1[0] * v1[0] + v1[1] * v1[1]) + (v1[2] * v1[2] + v1[3] * v1[3]);
                    u32x4 w; w.x = cvt_pk_bf16(v0[0], v0[1]); w.y = cvt_pk_bf16(v0[2], v0[3]); w.z = cvt_pk_bf16(v1[0], v1[1]); w.w = cvt_pk_bf16(v1[2], v1[3]);
                    *(u32x4*)(O + off + bj * HALF) = w; }
                ssq += __shfl_xor(ssq, 16); ssq += __shfl_xor(ssq, 32);
                if (fqv == 0) SS[(size_t)row * 16 + upn * 4 + wc] = ssq; }
    }
};
struct EpiF16Rstd {
    static constexpr bool PERM = true, AFTER_DRAIN = false, CHAIN = false;
    unsigned short* O; int ldc; const float* SS; float inv_nd, eps;
    __device__ __forceinline__ void operator()(const f32x4 (&acc)[2][2][4][2], const Unit& u, int wr, int wc, int fr, int fq) const {
        const int row0 = u.pm * BM + wr * 64 + fr, col0 = u.pn * BM + wc * 32 + 8 * fq;
#pragma unroll
        for (int ai = 0; ai < 2; ++ai)
#pragma unroll
            for (int m = 0; m < 4; ++m) { const int row = row0 + ai * HALF + m * 16; unsigned short* rowp = O + (size_t)row * ldc + col0;
                const f32x4* sp = (const f32x4*)(SS + (size_t)row * 16); const f32x4 s0 = sp[0], s1 = sp[1], s2 = sp[2], s3 = sp[3];
                const float tot = ((s0[0] + s0[1]) + (s0[2] + s0[3])) + ((s1[0] + s1[1]) + (s1[2] + s1[3])) + ((s2[0] + s2[1]) + (s2[2] + s2[3])) + ((s3[0] + s3[1]) + (s3[2] + s3[3]));
                const float rstd = 1.0f / __builtin_sqrtf(tot * inv_nd + eps);
#pragma unroll
                for (int bj = 0; bj < 2; ++bj) { const f32x4 v0 = acc[ai][bj][m][0] * rstd, v1 = acc[ai][bj][m][1] * rstd;
                    u32x4 w; w.x = EpiF16Plain::pkh(v0[0], v0[1]); w.y = EpiF16Plain::pkh(v0[2], v0[3]); w.z = EpiF16Plain::pkh(v1[0], v1[1]); w.w = EpiF16Plain::pkh(v1[2], v1[3]);
                    *(u32x4*)(rowp + bj * HALF) = w; } }
    }
};
struct EpiGateChain {
    static constexpr bool PERM = true, AFTER_DRAIN = false, CHAIN = true;
    bf16_t* T; int ldc; const bf16_t* GA; const bf16_t* GB; const float* bias;
    __device__ __forceinline__ static void gate8(const bf16_t* G, size_t off, float (&g)[8]) {
        if constexpr (GATE_FP8) { const u32x2 w = *(const u32x2*)((const unsigned char*)G + off);
            typedef float f2 __attribute__((ext_vector_type(2)));
            const f2 a = __builtin_amdgcn_cvt_pk_f32_fp8((int)w.x, false), b = __builtin_amdgcn_cvt_pk_f32_fp8((int)w.x, true), c = __builtin_amdgcn_cvt_pk_f32_fp8((int)w.y, false), d = __builtin_amdgcn_cvt_pk_f32_fp8((int)w.y, true);
            g[0] = a.x; g[1] = a.y; g[2] = b.x; g[3] = b.y; g[4] = c.x; g[5] = c.y; g[6] = d.x; g[7] = d.y; }
        else { const u32x4 w = *(const u32x4*)(G + off); g[0] = bf_lo(w.x); g[1] = bf_hi(w.x); g[2] = bf_lo(w.y); g[3] = bf_hi(w.y); g[4] = bf_lo(w.z); g[5] = bf_hi(w.z); g[6] = bf_lo(w.w); g[7] = bf_hi(w.w); }
    }
    __device__ __forceinline__ static float e_neg(float x) { return __builtin_amdgcn_exp2f(-1.4426950408889634f * fmaxf(x, -60.0f)); }
    __device__ __forceinline__ void mid(f32x4 (&acc)[2][2][4][2], const Unit& u, int wr, int wc, int fr, int fq) const {
        const int col0 = u.pn * BM + wc * 32 + 8 * fq;
        const size_t g0 = (size_t)(u.pm * 4 + u.pn) * 65536 + (size_t)(((wr * 4 + wc) * 64 + fq * 16 + fr) * 8);
        f32x4 bv[2][2];
#pragma unroll
        for (int bj = 0; bj < 2; ++bj)
#pragma unroll
            for (int n = 0; n < 2; ++n) bv[bj][n] = *(const f32x4*)(bias + col0 + bj * HALF + 4 * n);
#pragma unroll
        for (int ai = 0; ai < 2; ++ai)
#pragma unroll
            for (int m = 0; m < 4; ++m) {
#pragma unroll
                for (int bj = 0; bj < 2; ++bj) { const size_t goff = g0 + (size_t)(((ai * 4 + m) * 2 + bj) * 4096);
                    float ga8[8], gb8[8]; gate8(GA, goff, ga8); gate8(GB, goff, gb8);
#pragma unroll
                    for (int j = 0; j < 4; ++j) { const int n = j >> 1, c = 2 * (j & 1);
                        const float r0 = (1.0f + e_neg(ga8[2 * j])) * __builtin_amdgcn_rcpf(1.0f + e_neg(gb8[2 * j])), r1 = (1.0f + e_neg(ga8[2 * j + 1])) * __builtin_amdgcn_rcpf(1.0f + e_neg(gb8[2 * j + 1]));
                        acc[ai][bj][m][n][c] = (acc[ai][bj][m][n][c] + bv[bj][n][c]) * r0; acc[ai][bj][m][n][c + 1] = (acc[ai][bj][m][n][c + 1] + bv[bj][n][c + 1]) * r1; } } }
    }
    __device__ __forceinline__ void operator()(const f32x4 (&acc)[2][2][4][2], const Unit& u, int wr, int wc, int fr, int fq) const {
        const int row0 = u.pm * BM + wr * 64 + fr, col0 = u.pn * BM + wc * 32 + 8 * fq;
        const size_t g0 = (size_t)(u.pm * 4 + u.pn) * 65536 + (size_t)(((wr * 4 + wc) * 64 + fq * 16 + fr) * 8);
#pragma unroll
        for (int ai = 0; ai < 2; ++ai)
#pragma unroll
            for (int m = 0; m < 4; ++m) { const int row = row0 + ai * HALF + m * 16; bf16_t* rowp = T + (size_t)row * ldc + col0;
#pragma unroll
                for (int bj = 0; bj < 2; ++bj) { const f32x4 v0 = acc[ai][bj][m][0], v1 = acc[ai][bj][m][1];
                    float g8[8]; gate8(GA, g0 + (size_t)(((ai * 4 + m) * 2 + bj) * 4096), g8);
                    const float o0 = v0[0] * __builtin_amdgcn_rcpf(1.0f + e_neg(g8[0])), o1 = v0[1] * __builtin_amdgcn_rcpf(1.0f + e_neg(g8[1])), o2 = v0[2] * __builtin_amdgcn_rcpf(1.0f + e_neg(g8[2])), o3 = v0[3] * __builtin_amdgcn_rcpf(1.0f + e_neg(g8[3]));
                    const float o4 = v1[0] * __builtin_amdgcn_rcpf(1.0f + e_neg(g8[4])), o5 = v1[1] * __builtin_amdgcn_rcpf(1.0f + e_neg(g8[5])), o6 = v1[2] * __builtin_amdgcn_rcpf(1.0f + e_neg(g8[6])), o7 = v1[3] * __builtin_amdgcn_rcpf(1.0f + e_neg(g8[7]));
                    if constexpr (P6_FP8) { constexpr float sc = (float)(1 << P6_SA);
                        int p0 = __builtin_amdgcn_cvt_pk_fp8_f32(o0 * sc, o1 * sc, 0, false); p0 = __builtin_amdgcn_cvt_pk_fp8_f32(o2 * sc, o3 * sc, p0, true);
                        int p1 = __builtin_amdgcn_cvt_pk_fp8_f32(o4 * sc, o5 * sc, 0, false); p1 = __builtin_amdgcn_cvt_pk_fp8_f32(o6 * sc, o7 * sc, p1, true);
                        *(u32x2*)((unsigned char*)T + (size_t)row * ldc + col0 + bj * HALF) = (u32x2){(unsigned)p0, (unsigned)p1}; }
                    else { u32x4 w; w.x = cvt_pk_bf16(o0, o1); w.y = cvt_pk_bf16(o2, o3); w.z = cvt_pk_bf16(o4, o5); w.w = cvt_pk_bf16(o6, o7);
                        *(u32x4*)(rowp + bj * HALF) = w; } } }
    }
};
struct EpiProj {
    static constexpr bool PERM = true, AFTER_DRAIN = false, CHAIN = false;
    bf16_t *UVG, *QH, *KH, *VH, *GH, *GTA, *GTB; int pn0;
    template <long SA, long SM, long SB> __device__ __forceinline__ static void store_all(const f32x4 (&acc)[2][2][4][2], bf16_t* p) {
#pragma unroll
        for (int ai = 0; ai < 2; ++ai) {
#pragma unroll
            for (int m = 0; m < 4; ++m) {
#pragma unroll
                for (int bj = 0; bj < 2; ++bj) { const f32x4 v0 = acc[ai][bj][m][0], v1 = acc[ai][bj][m][1];
                    u32x4 w; w.x = cvt_pk_bf16(v0[0], v0[1]); w.y = cvt_pk_bf16(v0[2], v0[3]); w.z = cvt_pk_bf16(v1[0], v1[1]); w.w = cvt_pk_bf16(v1[2], v1[3]);
                    *(u32x4*)(p + bj * SB) = w; }
                p += SM; asm volatile("" : "+v"(p)); }
            p += SA - 4 * SM; }
    }
    __device__ __forceinline__ static void store_all8(unsigned char* p, const f32x4 (&acc)[2][2][4][2]) {
#pragma unroll
        for (int ai = 0; ai < 2; ++ai) {
#pragma unroll
            for (int m = 0; m < 4; ++m) {
#pragma unroll
                for (int bj = 0; bj < 2; ++bj) { const f32x4 v0 = acc[ai][bj][m][0], v1 = acc[ai][bj][m][1];
                    int p0 = __builtin_amdgcn_cvt_pk_fp8_f32(v0[0], v0[1], 0, false); p0 = __builtin_amdgcn_cvt_pk_fp8_f32(v0[2], v0[3], p0, true);
                    int p1 = __builtin_amdgcn_cvt_pk_fp8_f32(v1[0], v1[1], 0, false); p1 = __builtin_amdgcn_cvt_pk_fp8_f32(v1[2], v1[3], p1, true);
                    *(u32x2*)(p + bj * 4096) = (u32x2){(unsigned)p0, (unsigned)p1}; }
                p += 8192; asm volatile("" : "+v"(p)); }
            p += 32768 - 4 * 8192; }
    }
    __device__ __forceinline__ void operator()(const f32x4 (&acc)[2][2][4][2], const Unit& u, int wr, int wc, int fr, int fq) const {
        int upm = u.pm, upn = u.pn + pn0; asm volatile("" : "+s"(upm), "+s"(upn)); const int lnow = mk_lane(), frv = lnow & 15, fqv = lnow >> 4;
        const int cl0 = wc * 32 + 8 * fqv, tok0 = wr * 64 + frv;
        const int item0 = ((upm >> 4) * 32 + 2 * (upm & 15)) * 4;
        if (upn >= 10) { if constexpr (GATE_FP8) store_all8((unsigned char*)(upn < 14 ? GTA : GTB) + (size_t)(upm * 4 + ((upn - 10) & 3)) * 65536 + (int)(((wr * 4 + wc) * 64 + fqv * 16 + frv) * 8), acc);
                         else store_all<32768L, 8192L, 4096L>(acc, (upn < 14 ? GTA : GTB) + (size_t)(upm * 4 + ((upn - 10) & 3)) * 65536 + (int)(((wr * 4 + wc) * 64 + fqv * 16 + frv) * 8)); }
        else if (upn >= 6) store_all<(long)HALF * 1024, 16L * 1024, (long)HALF>(acc, UVG + ((size_t)(upm * BM) * 1024 + (upn - 6) * BM) + (int)(tok0 * 1024 + cl0));
        else if (upn < 2) store_all<4L * 128 * 64, 16L * 64, 2L * 128 * 64>(acc, (upn == 0 ? QH : KH) + (size_t)item0 * 8192 + (int)(((cl0 >> 6) * 128 + tok0) * 64 + (cl0 & 63)));
        else store_all<4L * 128 * 128, 16L * 128, 128L * 128>(acc, (upn < 4 ? VH : GH) + (size_t)(item0 + (upn & 1) * 2) * 16384 + (int)(tok0 * 128 + cl0));
    }
};


template <class Epi, class Sched, bool ALIGN_EPI = false, bool SP2 = false, bool FP8 = false, int FP8_SA = 0, int FP8_SB = 0>
__device__ __forceinline__ void gemm_phase(PG8_LAS unsigned char* lds, const Gemm g, const Sched& S, const Epi& E, const int wid  ) {
    const int lane = mk_lane(), tid = wid * 64 + lane, wr = wid >> 2, wc = wid & 3, fr = lane & 15, fq = lane >> 4;
    const int K = g.K, KB = FP8 ? K : 2 * K  , nt = KB / (BK * 2);
    unsigned voffA, voffB;
    { int R, C; stage_rc(tid * 16, R, C); const int Rb = Epi::PERM ? ((R & ~31) + perm32(R & 31)) : R;
        voffA = (unsigned)(R * KB + C * 2); voffB = (unsigned)(Rb * KB + C * 2); }
    const size_t kstep = (size_t)(BK * 2);
    const size_t hstep = (size_t)HALF * KB;
    const size_t tstep = 2 * hstep;
    const unsigned ldsw = (unsigned)wid * 1024u;
    const int aoff = lds_byte(wr * 64 + fr, fq * 8), boff = lds_byte(wc * 32 + fr, fq * 8);
#define PG8_SA(b, h) (((b) * 2 + (h)) * HTB)
#define PG8_SB(b, h) ((4 + (b) * 2 + (h)) * HTB)
#define PG8_STAGE(bufoff, gbase, voff) do { _Pragma("unroll") for (int _i = 0; _i < 2; ++_i) \
        __builtin_amdgcn_global_load_lds((const unsigned*)((const char*)(gbase) + (size_t)_i * 64 * KB + (voff)), (PG8_LAS unsigned*)(lds + (bufoff) + ldsw + _i * 8192), 16, 0, 0); } while (0)
#define PG8_LDA(dst, b, h) do { _Pragma("unroll") for (int m = 0; m < 4; ++m) _Pragma("unroll") for (int k = 0; k < 2; ++k) dst[m][k] = *(const PG8_LAS bf16x8*)(lds + PG8_SA(b, h) + aoff + m * 2048 + k * 1024); } while (0)
#define PG8_LDB(dst, b, h) do { _Pragma("unroll") for (int n = 0; n < 2; ++n) _Pragma("unroll") for (int k = 0; k < 2; ++k) dst[n][k] = *(const PG8_LAS bf16x8*)(lds + PG8_SB(b, h) + boff + n * 2048 + k * 1024); } while (0)
#define PG8_MMA(ai, bj, At, Bt) do { __builtin_amdgcn_s_setprio(1); _Pragma("unroll") for (int m = 0; m < 4; ++m) _Pragma("unroll") for (int n = 0; n < 2; ++n) { \
        if constexpr (FP8) { const v4i_t b0 = __builtin_bit_cast(v4i_t, Bt[n][0]), b1 = __builtin_bit_cast(v4i_t, Bt[n][1]), a0 = __builtin_bit_cast(v4i_t, At[m][0]), a1 = __builtin_bit_cast(v4i_t, At[m][1]); \
            acc[ai][bj][m][n] = __builtin_amdgcn_mfma_scale_f32_16x16x128_f8f6f4(__builtin_shufflevector(b0, b1, 0, 1, 2, 3, 4, 5, 6, 7), __builtin_shufflevector(a0, a1, 0, 1, 2, 3, 4, 5, 6, 7), acc[ai][bj][m][n], 0, 0, \
                0, 0, 0, 0); }   \
        else { _Pragma("unroll") for (int k = 0; k < 2; ++k) acc[ai][bj][m][n] = __builtin_amdgcn_mfma_f32_16x16x32_bf16(Bt[n][k], At[m][k], acc[ai][bj][m][n], 0, 0, 0); } } __builtin_amdgcn_s_setprio(0); } while (0)
#define PG8_WAIT_V(n) asm volatile("s_waitcnt vmcnt(" #n ")" ::: "memory")
#define PG8_WAIT_L(n) asm volatile("s_waitcnt lgkmcnt(" #n ")" ::: "memory")
#define PG8_BAR __builtin_amdgcn_s_barrier()
#define PG8_SCHED __builtin_amdgcn_sched_barrier(0)
    Unit cur, nxt; int ui = 0;
    if (!S.next(0, cur)) return;
    f32x4 acc[2][2][4][2];
#pragma unroll
    for (int a = 0; a < 2; ++a)
#pragma unroll
        for (int b = 0; b < 2; ++b)
#pragma unroll
            for (int m = 0; m < 4; ++m)
#pragma unroll
                for (int n = 0; n < 2; ++n) acc[a][b][m][n] = (f32x4){0.f, 0.f, 0.f, 0.f};
    bf16x8 At[4][2], B0[2][2], B1[2][2];
    const char* cA = (const char*)(cur.br ? g.A2 : g.A) + (size_t)cur.pm * tstep; const char* cB = (const char*)(cur.br ? g.Bt2 : g.Bt) + (size_t)cur.pn * tstep;
    S.a_ready(cur);
    if constexpr (SP2) {
        PG8_STAGE(PG8_SB(0, 0), cB, voffB); PG8_STAGE(PG8_SB(0, 1), cB + hstep, voffB); PG8_STAGE(PG8_SA(0, 0), cA, voffA); PG8_STAGE(PG8_SA(0, 1), cA + hstep, voffA);
        if (wr == 1) PG8_BAR;
        PG8_WAIT_V(2); PG8_BAR;
        PG8_STAGE(PG8_SB(1, 0), cB + kstep, voffB); PG8_STAGE(PG8_SA(1, 0), cA + kstep, voffA); PG8_STAGE(PG8_SB(1, 1), cB + hstep + kstep, voffB);
        PG8_WAIT_V(6); PG8_BAR;
    } else {
        PG8_STAGE(PG8_SB(0, 0), cB, voffB); PG8_STAGE(PG8_SA(0, 0), cA, voffA); PG8_STAGE(PG8_SB(0, 1), cB + hstep, voffB); PG8_STAGE(PG8_SA(0, 1), cA + hstep, voffA);
        if (wr == 1) PG8_BAR;
        PG8_WAIT_V(4); PG8_BAR;
        PG8_STAGE(PG8_SB(1, 0), cB + kstep, voffB); PG8_STAGE(PG8_SA(1, 0), cA + kstep, voffA); PG8_STAGE(PG8_SB(1, 1), cB + hstep + kstep, voffB);
        PG8_WAIT_V(6); PG8_BAR;
    }
    for (;;) {
        const bool has_next = S.next(ui + 1, nxt);
        const char* nA = has_next ? (const char*)(nxt.br ? g.A2 : g.A) + (size_t)nxt.pm * tstep : cA; const char* nB = has_next ? (const char*)(nxt.br ? g.Bt2 : g.Bt) + (size_t)nxt.pn * tstep : cB;
#pragma unroll 1
        for (int t = 0; t < nt; t += 2) {
            const bool last = (t == nt - 2);
            const char* a1 = cA + (size_t)(t + 1) * kstep;
            const char* a2 = last ? nA : cA + (size_t)(t + 2) * kstep; const char* b2 = last ? nB : cB + (size_t)(t + 2) * kstep;
            const char* a3 = a2 + kstep; const char* b3 = b2 + kstep;
            if (last && has_next) S.a_ready(nxt);
            if constexpr (SP2) {
            PG8_LDB(B0, 0, 0); PG8_LDB(B1, 0, 1); PG8_SCHED; PG8_LDA(At, 0, 0); PG8_STAGE(PG8_SA(1, 1), a1 + hstep, voffA);
            PG8_WAIT_V(8); PG8_WAIT_L(0); PG8_BAR; PG8_MMA(0, 0, At, B0); PG8_MMA(0, 1, At, B1); PG8_BAR; PG8_SCHED;
            PG8_LDA(At, 0, 1); PG8_STAGE(PG8_SB(0, 0), b2, voffB); PG8_STAGE(PG8_SB(0, 1), b2 + hstep, voffB); PG8_STAGE(PG8_SA(0, 0), a2, voffA);
            PG8_WAIT_V(8); PG8_WAIT_L(0); PG8_BAR; PG8_MMA(1, 0, At, B0); PG8_MMA(1, 1, At, B1); PG8_BAR; PG8_SCHED;
            PG8_LDB(B0, 1, 0); PG8_LDB(B1, 1, 1); PG8_SCHED; PG8_LDA(At, 1, 0); PG8_STAGE(PG8_SA(0, 1), a2 + hstep, voffA);
            PG8_WAIT_V(8); PG8_WAIT_L(0); PG8_BAR; PG8_MMA(0, 0, At, B0); PG8_MMA(0, 1, At, B1); PG8_BAR; PG8_SCHED;
            PG8_LDA(At, 1, 1); PG8_STAGE(PG8_SB(1, 0), b3, voffB); PG8_STAGE(PG8_SB(1, 1), b3 + hstep, voffB); PG8_STAGE(PG8_SA(1, 0), a3, voffA);
            PG8_WAIT_V(8); PG8_WAIT_L(0); PG8_BAR; PG8_MMA(1, 0, At, B0); PG8_MMA(1, 1, At, B1); PG8_BAR; PG8_SCHED;
            } else {
            PG8_LDB(B0, 0, 0); PG8_SCHED; PG8_LDA(At, 0, 0); PG8_STAGE(PG8_SA(1, 1), a1 + hstep, voffA);
            PG8_WAIT_L(8); PG8_BAR; PG8_WAIT_L(0); PG8_MMA(0, 0, At, B0); PG8_BAR; PG8_SCHED;
            PG8_LDB(B1, 0, 1); PG8_STAGE(PG8_SB(0, 0), b2, voffB);
            PG8_BAR; PG8_WAIT_L(0); PG8_MMA(0, 1, At, B1); PG8_BAR;
            PG8_LDA(At, 0, 1); PG8_STAGE(PG8_SA(0, 0), a2, voffA);
            PG8_BAR; PG8_WAIT_L(0); PG8_MMA(1, 0, At, B0); PG8_BAR; PG8_SCHED;
            PG8_STAGE(PG8_SB(0, 1), b2 + hstep, voffB);
            PG8_WAIT_V(6); PG8_BAR; PG8_MMA(1, 1, At, B1); PG8_BAR;
            PG8_LDB(B0, 1, 0); PG8_SCHED; PG8_LDA(At, 1, 0); PG8_STAGE(PG8_SA(0, 1), a2 + hstep, voffA);
            PG8_WAIT_L(8); PG8_BAR; PG8_WAIT_L(0); PG8_MMA(0, 0, At, B0); PG8_BAR; PG8_SCHED;
            PG8_LDB(B1, 1, 1); PG8_STAGE(PG8_SB(1, 0), b3, voffB);
            PG8_BAR; PG8_WAIT_L(0); PG8_MMA(0, 1, At, B1); PG8_BAR;
            PG8_LDA(At, 1, 1); PG8_STAGE(PG8_SA(1, 0), a3, voffA);
            PG8_BAR; PG8_WAIT_L(0); PG8_MMA(1, 0, At, B0); PG8_BAR; PG8_SCHED;
            PG8_STAGE(PG8_SB(1, 1), b3 + hstep, voffB);
            PG8_WAIT_V(6); PG8_BAR; PG8_MMA(1, 1, At, B1); PG8_BAR;
            }
        }
        if constexpr (ALIGN_EPI) { if (wr == 0) PG8_BAR; }
        if constexpr (FP8) {
#pragma unroll
            for (int a = 0; a < 2; ++a)
#pragma unroll
                for (int b = 0; b < 2; ++b)
#pragma unroll
                    for (int m = 0; m < 4; ++m)
#pragma unroll
                        for (int n = 0; n < 2; ++n) acc[a][b][m][n] *= 1.0f / (float)(1 << (FP8_SA + FP8_SB));
        }
        bool carry = false;
        if constexpr (Epi::CHAIN) { if (cur.br == 0) { E.mid(acc, cur, wr, wc, fr, fq); carry = true; } else E(acc, cur, wr, wc, fr, fq); }
        else if constexpr (!Epi::AFTER_DRAIN) { E(acc, cur, wr, wc, fr, fq); S.done(cur); }
        if (!has_next) break;
        if (!carry)
#pragma unroll
        for (int a = 0; a < 2; ++a)
#pragma unroll
            for (int b = 0; b < 2; ++b)
#pragma unroll
                for (int m = 0; m < 4; ++m)
#pragma unroll
                    for (int n = 0; n < 2; ++n) acc[a][b][m][n] = (f32x4){0.f, 0.f, 0.f, 0.f};
        cur = nxt; cA = nA; cB = nB; ++ui;
        if constexpr (ALIGN_EPI) { if (wr == 1) PG8_BAR; }
    }
    PG8_WAIT_V(0);
    if constexpr (!ALIGN_EPI) { if (wr == 0) PG8_BAR; }
    PG8_BAR;
    if constexpr (Epi::AFTER_DRAIN) { E.fused(acc, cur, wr, wc, fr, fq, lds, wid, lane); S.done(cur); }
#undef PG8_SA
#undef PG8_SB
#undef PG8_STAGE
#undef PG8_LDA
#undef PG8_LDB
#undef PG8_MMA
#undef PG8_WAIT_V
#undef PG8_WAIT_L
#undef PG8_BAR
#undef PG8_SCHED
}
}

constexpr int NWAVES = 8;
#ifndef MK_PER_PHASE
#define MK_PER_PHASE 0
#endif
constexpr int N_PHASES = 10;
#ifndef DBG_OUT
#define DBG_OUT 0
#endif
#ifndef DBG_SAN
#define DBG_SAN 0
#endif
#ifndef DBG_PROBE
#define DBG_PROBE 0
#endif
#define DBG_P1 (F.PROJ + t * NIN)
#define DBG_N1 (NIN / 8)
#define DBG_P2 (F.RA + t * RW)
#define DBG_N2 (RW / 8)
#define DBG_P3 (F.CB + t * CCH)
#define DBG_N3 (CCH / 8)
#ifndef DBG_ZFILL
#define DBG_ZFILL 0
#endif
#ifndef DBG_PHASE_MASK
#define DBG_PHASE_MASK 0x3ff
#endif
#ifndef DBG_REPEAT
#define DBG_REPEAT 0
#endif
#ifndef DBG_P0REP
#define DBG_P0REP 0
#endif
#ifndef DBG_DOUBLE_BAR
#define DBG_DOUBLE_BAR 0
#endif
#ifndef DBG_CONVREP
#define DBG_CONVREP 0
#endif
#ifndef DBG_DUMMY_EMASK
#define DBG_DUMMY_EMASK 0
#endif
#ifndef DBG_P9_VR
#define DBG_P9_VR 2
#endif
#ifndef DBG_ZF
#define DBG_ZF 1.0f
#endif
#ifndef DBG_TOPKREP
#define DBG_TOPKREP 0
#endif
#ifndef DBG_PRIO9
#define DBG_PRIO9 0
#endif
#ifndef DBG_SKIP_AXPY
#define DBG_SKIP_AXPY 0
#endif
#ifndef PG8_SP2
#define PG8_SP2 true
#endif
#ifndef PG8_ALIGN
#define PG8_ALIGN true
#endif

constexpr int BATCH = 8, SEQ = 4096, D = 1024, M = BATCH * SEQ;
constexpr int RH = 4, RDK = 64, RDV = 128, RW = 512, RC = 128, NCH = SEQ / RC;
constexpr int CCH = 512, CK = 31;
constexpr int NIN = 4608, NUVG = 1024;
constexpr int C_UV = 0, C_UG = 512;
constexpr int PH = 8, PQ = 256, PHALF = 128, NKEY = 128, NEXP = 16384, TOPK = 16, NSC = 2048;
constexpr float RMS_EPS = 1e-6f, LN_EPS = 1e-5f;

constexpr size_t MiB = 1u << 20;
constexpr size_t WS_CTL = 0, CTL_ZERO_BYTES = 64 * 1024;
constexpr size_t WS_ROPE = 1 * MiB;
constexpr size_t WS_WIN = 2 * MiB, WS_WR = 11 * MiB, WS_WC = 12 * MiB, WS_WO = 13 * MiB, WS_WQ = 15 * MiB;
constexpr size_t WS_UT = 20 * MiB, WS_VT = 28 * MiB, WS_USC = 52 * MiB, WS_VSC = 52 * MiB + 65536;
constexpr size_t WS_XN = 84 * MiB;
constexpr size_t WS_PROJ = 148 * MiB, WS_GTA = 212 * MiB, WS_GTB = 276 * MiB;
constexpr size_t WS_SC = WS_PROJ, WS_X1 = WS_PROJ + 128 * MiB, WS_SS = WS_PROJ + 192 * MiB;
constexpr size_t WS_XN8 = 342 * MiB, WS_WIN8 = 374 * MiB;
constexpr size_t WS_S = 436 * MiB;
constexpr size_t WS_QH = 452 * MiB, WS_KH = 468 * MiB;
constexpr size_t WS_END = 500 * MiB;
constexpr int CW_TMO = 0, CW_CODE = 1, CW_BAR = 4096;

constexpr int RING_OFF = 0, RING_BYTES = 131072;
constexpr int LDSCTL_OFF = RING_BYTES, MISC_OFF = LDSCTL_OFF + 320;
constexpr int LDS_BYTES = 147456;
static_assert(MISC_OFF + 128 <= LDS_BYTES, "LDS map");

#define GAS __attribute__((address_space(1)))
#define LAS __attribute__((address_space(3)))
typedef unsigned short bf16;
typedef unsigned v4u __attribute__((ext_vector_type(4)));
typedef unsigned v2u __attribute__((ext_vector_type(2)));
typedef float f32x4 __attribute__((ext_vector_type(4)));
typedef float f32x2 __attribute__((ext_vector_type(2)));
typedef short bf16x8 __attribute__((ext_vector_type(8)));
typedef __bf16 bf16x2v __attribute__((ext_vector_type(2)));
typedef GAS unsigned gu32;
#define RLX_AGENT __ATOMIC_RELAXED, __HIP_MEMORY_SCOPE_AGENT
#define LDS_WAIT() asm volatile("s_waitcnt lgkmcnt(0)" ::: "memory")
#define VM_WAIT() asm volatile("s_waitcnt vmcnt(0)" ::: "memory")
__device__ __forceinline__ unsigned f2bf(float f) { unsigned u = __builtin_bit_cast(unsigned, f); return (u + 0x7fffu + ((u >> 16) & 1u)) >> 16; }
__device__ __forceinline__ unsigned pk2(float lo, float hi) { return pg8::cvt_pk_bf16(lo, hi); }
__device__ __forceinline__ float bflo(unsigned w) { return __builtin_bit_cast(float, w << 16); }
__device__ __forceinline__ float bfhi(unsigned w) { return __builtin_bit_cast(float, w & 0xffff0000u); }
__device__ __forceinline__ float bf1(bf16 b) { return __builtin_bit_cast(float, (unsigned)b << 16); }
__device__ __forceinline__ float dot2bf(unsigned a, unsigned b, float acc) { return __builtin_amdgcn_fdot2_f32_bf16(__builtin_bit_cast(bf16x2v, a), __builtin_bit_cast(bf16x2v, b), acc, false); }
__device__ __forceinline__ float sigm(float x) { return __builtin_amdgcn_rcpf(1.0f + __builtin_amdgcn_exp2f(-1.4426950408889634f * x)); }
__device__ __forceinline__ float wave_sum(float v) {
#pragma unroll
    for (int o = 1; o < 64; o <<= 1) v += __shfl_xor(v, o);
    return v;
}

template <int CTRL, int RM = 0xf> __device__ __forceinline__ float dpp_get(float v) { return __builtin_bit_cast(float, __builtin_amdgcn_update_dpp(0, __builtin_bit_cast(int, v), CTRL, RM, 0xf, true)); }
__device__ __forceinline__ float quad_sum(float v) { v += dpp_get<0xB1>(v); v += dpp_get<0x4E>(v); return v; }
__device__ __forceinline__ float row16_sum(float v) { v = quad_sum(v); v += dpp_get<0x141>(v); v += dpp_get<0x140>(v); return v; }
__device__ __forceinline__ float wave_sum_dpp(float v) { v = row16_sum(v); v += dpp_get<0x142, 0xa>(v); v += dpp_get<0x143, 0xc>(v);
    return __builtin_bit_cast(float, __builtin_amdgcn_readlane(__builtin_bit_cast(int, v), 63)); }
__device__ __forceinline__ float wave_max_dpp(float v) {
    v = fmaxf(v, dpp_get<0xB1>(v)); v = fmaxf(v, dpp_get<0x4E>(v)); v = fmaxf(v, dpp_get<0x141>(v)); v = fmaxf(v, dpp_get<0x140>(v)); v = fmaxf(v, dpp_get<0x142, 0xa>(v)); v = fmaxf(v, dpp_get<0x143, 0xc>(v));
    return __builtin_bit_cast(float, __builtin_amdgcn_readlane(__builtin_bit_cast(int, v), 63)); }

#define XB_TMO      128
#define XB_XCNT(j)  (256  + 64 * (j))
#define XB_XSUB(j)  (1280 + 64 * (j))
#define XB_XGEN(j)  (2304 + 64 * (j))
#define XB_TOP      3328
#define XB_TOPGEN   3392
#define XCD_BAR_WORDS 3456
#define XB_SPIN_CAP (1u << 20)

__device__ __forceinline__ unsigned xb_ld(unsigned* p)              { return __hip_atomic_load(p, __ATOMIC_RELAXED, __HIP_MEMORY_SCOPE_AGENT); }
__device__ __forceinline__ unsigned xb_add(unsigned* p, unsigned v) { return __hip_atomic_fetch_add(p, v, __ATOMIC_RELAXED, __HIP_MEMORY_SCOPE_AGENT); }
__device__ __forceinline__ unsigned xb_xcc_id() { return (unsigned)__builtin_amdgcn_s_getreg((3 << 11) | 20) & 0xFu; }
#define XB_SPIN(cond, bar) do { unsigned _sp = 0; while (cond) { __builtin_amdgcn_s_sleep(1); \
    if ((++_sp & 255u) == 0u) { if (xb_ld(&(bar)[XB_TMO])) break; if (_sp > XB_SPIN_CAP) { atomicAdd(&(bar)[XB_TMO], 1u); break; } } } } while (0)

struct XcdBarrier { unsigned* bar; unsigned x; volatile LAS unsigned* st; int wave; };

__device__ __forceinline__ XcdBarrier xcd_barrier_post(unsigned* bar, volatile LAS unsigned* st, int wave) {
    XcdBarrier b; b.bar = bar; b.x = xb_xcc_id(); b.st = st; b.wave = wave;
    if (wave == 0 && mk_lane() == 0) (void)xb_add(&bar[XB_XCNT(b.x)], 1u);
    return b;
}
__device__ __forceinline__ void xcd_barrier_complete(unsigned* bar, unsigned x, unsigned& nloc, unsigned& nx) {
    const unsigned G = gridDim.x * gridDim.y * gridDim.z;
    unsigned sum, cnt, mine, sp = 0u;
    for (;;) {
        sum = 0u; cnt = 0u; mine = 0u;
#pragma unroll
        for (unsigned j = 0; j < 16; ++j) { const unsigned c = xb_ld(&bar[XB_XCNT(j)]); sum += c; cnt += (c > 0u) ? 1u : 0u; mine = (j == x) ? c : mine; }
        if (sum == G) break;
        __builtin_amdgcn_s_sleep(1);
        if ((++sp & 255u) == 0u) { if (xb_ld(&bar[XB_TMO])) break; if (sp > XB_SPIN_CAP) { atomicAdd(&bar[XB_TMO], 1u); break; } }
    }
    nloc = mine > 0u ? mine : 1u; nx = cnt > 0u ? cnt : 1u;
}
__device__ __forceinline__ void xcd_barrier(const XcdBarrier& b) {
    asm volatile("s_waitcnt vmcnt(0)" ::: "memory");
    __syncthreads();
    if (b.wave == 0 && mk_lane() == 0) {
        unsigned* bar = b.bar;
        __builtin_amdgcn_s_waitcnt(0);
        unsigned nloc = b.st[0], nx = b.st[1];
        if (nloc == 0u) { xcd_barrier_complete(bar, b.x, nloc, nx); b.st[0] = nloc; b.st[1] = nx; }
        const unsigned old = xb_add(&bar[XB_XSUB(b.x)], 1u);
        const unsigned gen = old / nloc;
        if (old + 1u == (gen + 1u) * nloc) {
            __builtin_amdgcn_fence(__ATOMIC_RELEASE, "agent");
            asm volatile("s_waitcnt vmcnt(0)" ::: "memory");
            const unsigned og = xb_add(&bar[XB_TOP], 1u);
            const unsigned tg = og / nx;
            if (og + 1u == (tg + 1u) * nx) xb_add(&bar[XB_TOPGEN], 1u);
            else XB_SPIN(xb_ld(&bar[XB_TOPGEN]) == tg, bar);
            __builtin_amdgcn_fence(__ATOMIC_ACQUIRE, "agent");
            xb_add(&bar[XB_XGEN(b.x)], 1u);
            asm volatile("s_waitcnt vmcnt(0)" ::: "memory");
        } else {
            XB_SPIN(xb_ld(&bar[XB_XGEN(b.x)]) == gen, bar);
            __builtin_amdgcn_fence(__ATOMIC_ACQUIRE, "agent");
            asm volatile("s_waitcnt vmcnt(0)" ::: "memory");
        }
    }
    __syncthreads();
}

struct Frame {
    LAS unsigned char* lds;
    volatile LAS unsigned* MISC;
    gu32* ctl;
    int tid, lane, wave;
    int vcu, G;
    const float *x, *rms_mix_g, *w_in, *ret_gn_g, *conv_dw_w, *conv_dw_b, *conv_ln_g, *conv_ln_b, *w_ret_proj, *w_conv_proj, *b_conv_proj, *w_out, *rms_ffn_g, *w_query, *sub_keys, *peer_u, *peer_v, *rms_final_g;
    float* out;
    f32x2* ROPE; bf16 *WinT, *WrT, *WcT, *WoT, *WqT, *XN, *PROJ, *S, *RA, *CB, *QH, *KH, *VH, *GH, *GTA, *GTB; unsigned char *UT, *VT, *XN8, *WinT8; float *USC, *VSC; unsigned short* SC; bf16* X1; float* SS;
};

template <bool FP8 = false, int SH = 0> __device__ __forceinline__ void p0_transpose_item(const float* W, int K, int N, bf16* WT, LAS float* scr, int item, int lane, int nsub = 0) {
    const int nblk = N / 32, kb = item / nblk, nb = item % nblk, k0 = 64 * kb, n0 = 32 * nb;
#pragma unroll 8
    for (int i = 0; i < 32; ++i) { const int kk = 2 * i + (lane >> 5); scr[kk * 33 + (lane & 31)] = W[(size_t)(k0 + kk) * N + n0 + (lane & 31)]; }
    LDS_WAIT(); asm volatile("" ::: "memory");
    const int c = lane & 7;
#pragma unroll
    for (int j = 0; j < 4; ++j) { const int n = (lane >> 3) + 8 * j; const LAS float* s = scr + (8 * c) * 33 + n;
        if constexpr (FP8) { constexpr float sc = (float)(1 << SH); v2u o;
            { int p = __builtin_amdgcn_cvt_pk_fp8_f32(s[0 * 33] * sc, s[1 * 33] * sc, 0, false); p = __builtin_amdgcn_cvt_pk_fp8_f32(s[2 * 33] * sc, s[3 * 33] * sc, p, true); o.x = (unsigned)p; }
            { int p = __builtin_amdgcn_cvt_pk_fp8_f32(s[4 * 33] * sc, s[5 * 33] * sc, 0, false); p = __builtin_amdgcn_cvt_pk_fp8_f32(s[6 * 33] * sc, s[7 * 33] * sc, p, true); o.y = (unsigned)p; }
            *(v2u*)((unsigned char*)WT + (size_t)(n0 + n - nsub) * K + k0 + 8 * c) = o; }
        else { v4u o; o.x = pk2(s[0 * 33], s[1 * 33]); o.y = pk2(s[2 * 33], s[3 * 33]); o.z = pk2(s[4 * 33], s[5 * 33]); o.w = pk2(s[6 * 33], s[7 * 33]);
            *(v4u*)(WT + (size_t)(n0 + n - nsub) * K + k0 + 8 * c) = o; } }
    LDS_WAIT(); asm volatile("" ::: "memory");
}
template <int R, bool FP8 = false, int SH = 0> __device__ __forceinline__ void rms_rows_to_bf16(int lane, const float* xrow, const float* g, bf16* orow, unsigned char* orow8 = nullptr) {
    const f32x4* gr = (const f32x4*)g + lane;
    f32x4 v[R][4]; float s[R];
#pragma unroll
    for (int r = 0; r < R; ++r) { const f32x4* xr = (const f32x4*)(xrow + (size_t)r * D) + lane;
#pragma unroll
        for (int j = 0; j < 4; ++j) v[r][j] = xr[64 * j]; }
#pragma unroll
    for (int r = 0; r < R; ++r) { float a = 0.f;
#pragma unroll
        for (int j = 0; j < 4; ++j) a += (v[r][j].x * v[r][j].x + v[r][j].y * v[r][j].y) + (v[r][j].z * v[r][j].z + v[r][j].w * v[r][j].w);
        s[r] = a; }
#pragma unroll
    for (int o = 1; o < 64; o <<= 1) {
#pragma unroll
        for (int r = 0; r < R; ++r) s[r] += __shfl_xor(s[r], o); }
    f32x4 gg[4];
#pragma unroll
    for (int j = 0; j < 4; ++j) gg[j] = gr[64 * j];
#pragma unroll
    for (int r = 0; r < R; ++r) { const float rstd = 1.f / sqrtf(s[r] * (1.f / D) + RMS_EPS);
        if constexpr (FP8) { unsigned* o4 = (unsigned*)(orow8 + (size_t)r * D) + lane; constexpr float sc = (float)(1 << SH);
#pragma unroll
            for (int j = 0; j < 4; ++j) { int p = __builtin_amdgcn_cvt_pk_fp8_f32(v[r][j].x * rstd * gg[j].x * sc, v[r][j].y * rstd * gg[j].y * sc, 0, false); p = __builtin_amdgcn_cvt_pk_fp8_f32(v[r][j].z * rstd * gg[j].z * sc, v[r][j].w * rstd * gg[j].w * sc, p, true); o4[64 * j] = (unsigned)p; } }
        { v2u* o8 = (v2u*)(orow + (size_t)r * D) + lane;
#pragma unroll
            for (int j = 0; j < 4; ++j) { v2u o; o.x = pk2(v[r][j].x * rstd * gg[j].x, v[r][j].y * rstd * gg[j].y); o.y = pk2(v[r][j].z * rstd * gg[j].z, v[r][j].w * rstd * gg[j].w); o8[64 * j] = o; } } }
}
__device__ __forceinline__ void p0_fold_task(Frame& F, int task) {
    const int nq = task & 7, kg = (task >> 3) & 15, hp = task >> 7;
    const int k = kg * 64 + F.lane;
    const f32x4* wq = (const f32x4*)(F.w_query + (size_t)k * (PH * PQ) + hp * 128);
    f32x4 w[32];
#pragma unroll
    for (int i = 0; i < 32; ++i) w[i] = wq[i];
    const float gk = F.rms_ffn_g[k];
    for (int n = nq * 16; n < nq * 16 + 16; ++n) {
        const f32x4* sk = (const f32x4*)(F.sub_keys + ((size_t)hp * 128 + n) * 128);
        float a0 = 0.f, a1 = 0.f, a2 = 0.f, a3 = 0.f;
#pragma unroll
        for (int i = 0; i < 32; ++i) { const f32x4 s = sk[i]; a0 += s.x * w[i].x; a1 += s.y * w[i].y; a2 += s.z * w[i].z; a3 += s.w * w[i].w; }
        F.WqT[(size_t)(hp * 128 + n) * D + k] = (bf16)f2bf(((a0 + a1) + (a2 + a3)) * gk);
    }
}
__device__ __forceinline__ void p0_prologue(Frame& F) {
    LAS float* scr = (LAS float*)(F.lds + RING_OFF + F.wave * 16384);
    const int gw = F.vcu * NWAVES + F.wave, NGW = F.G * NWAVES;
    if (!(F.wave & 1)) {
    for (int rep = 0; rep < 1 + ((DBG_P0REP >> 0) & 1); ++rep)
    for (int it = gw; it < 2048; it += NGW) p0_fold_task(F, it);
    }
    constexpr int I_IN = (D / 64) * (NIN / 32), I_R = (RW / 64) * (D / 32), I_C = (CCH / 64) * (D / 32), I_O = (D / 64) * (D / 32);
    constexpr int NITEMS = I_IN + I_R + I_C + I_O;
    for (int rep = 0; rep < 1 + ((DBG_P0REP >> 1) & 1); ++rep)
    for (int it = gw; it < NITEMS; it += NGW) {
        int r = it;
        if (r < I_IN) {
            if (P1_FP8 && (r % (NIN / 32)) * 32 >= P1_NB) p0_transpose_item<true, P1_SB>(F.w_in, D, NIN, (bf16*)F.WinT8, scr, r, F.lane, P1_NB); else p0_transpose_item(F.w_in, D, NIN, F.WinT, scr, r, F.lane);
            continue; } r -= I_IN;
        if (r < I_R) { p0_transpose_item(F.w_ret_proj, RW, D, F.WrT, scr, r, F.lane); continue; } r -= I_R;
        if (r < I_C) { p0_transpose_item(F.w_conv_proj, CCH, D, F.WcT, scr, r, F.lane); continue; } r -= I_C;
        p0_transpose_item<P6_FP8, P6_SB>(F.w_out, D, D, F.WoT, scr, r, F.lane);
    }
    for (int rep = 0; rep < 1 + ((DBG_P0REP >> 2) & 1); ++rep)
    for (int m = gw * 4; m < M; m += NGW * 4) rms_rows_to_bf16<4, P1_FP8, P1_SA>(F.lane, F.x + (size_t)m * D, F.rms_mix_g, F.XN + (size_t)m * D, F.XN8 + (size_t)m * D);
    for (int rep = 0; rep < 1 + ((DBG_P0REP >> 3) & 1); ++rep)
    for (int r0 = gw * 4; r0 < 2 * NEXP; r0 += NGW * 4) {
        const bool isv = r0 >= NEXP; const int row0 = isv ? r0 - NEXP : r0;
        const float* base = (isv ? F.peer_v : F.peer_u) + (size_t)row0 * D;
        f32x4 v[4][4]; float ss[4];
#pragma unroll
        for (int r = 0; r < 4; ++r) { const f32x4* src = (const f32x4*)(base + (size_t)r * D) + 2 * F.lane;
            v[r][0] = src[0]; v[r][1] = src[1]; v[r][2] = src[128]; v[r][3] = src[129]; }
#pragma unroll
        for (int r = 0; r < 4; ++r) { float a = 0.f;
#pragma unroll
            for (int j = 0; j < 4; ++j) a += (v[r][j].x * v[r][j].x + v[r][j].y * v[r][j].y) + (v[r][j].z * v[r][j].z + v[r][j].w * v[r][j].w);
            ss[r] = a; }
#pragma unroll
        for (int o = 1; o < 64; o <<= 1) {
#pragma unroll
            for (int r = 0; r < 4; ++r) ss[r] += __shfl_xor(ss[r], o); }
#pragma unroll
        for (int r = 0; r < 4; ++r) {
            const float rms = ss[r] > 0.f ? sqrtf(ss[r] * (1.f / D)) : 1.0f;
            const float sc = 0.5f * rms, inv = 1.0f / sc;
            unsigned* dst = (unsigned*)(F.UT + (size_t)(row0 + r) * D + (isv ? D / 2 : 0)) + F.lane;
#pragma unroll
            for (int j = 0; j < 2; ++j) {
                const f32x4 a = v[r][2 * j], b = v[r][2 * j + 1];
                const float e[8] = {a.x, a.y, a.z, a.w, b.x, b.y, b.z, b.w}; unsigned w = 0u;
                w = __builtin_amdgcn_cvt_scalef32_pk_fp4_f32(w, e[0] * inv, e[1] * inv, 1.0f, 0);
                w = __builtin_amdgcn_cvt_scalef32_pk_fp4_f32(w, e[2] * inv, e[3] * inv, 1.0f, 1);
                w = __builtin_amdgcn_cvt_scalef32_pk_fp4_f32(w, e[4] * inv, e[5] * inv, 1.0f, 2);
                w = __builtin_amdgcn_cvt_scalef32_pk_fp4_f32(w, e[6] * inv, e[7] * inv, 1.0f, 3);
                dst[64 * j] = w;
            }
            if (F.lane == 0) ((_Float16*)F.USC)[2 * (row0 + r) + (isv ? 1 : 0)] = (_Float16)sc;
        }
    }
    {
        const size_t gt = (size_t)gw * 64 + F.lane, NT = (size_t)NGW * 64;
        for (size_t i = gt; i < (size_t)SEQ * 32; i += NT) {
            const int pos = (int)(i >> 5), fi = (int)(i & 31);
            double inv = 1.0; for (int j = 0; j < fi; ++j) inv *= 0.7498942093324559;
            double rev = (double)pos * inv * 0.15915494309189535; rev -= __builtin_floor(rev);
            const float r = (float)rev;
            F.ROPE[i] = (f32x2){__builtin_amdgcn_cosf(r), __builtin_amdgcn_sinf(r)};
        }
    }
    if (F.wave & 1) { for (int it = gw; it < 2048; it += NGW) p0_fold_task(F, it); }
}

__device__ __forceinline__ float lg2_gamma(int h) { return h == 0 ? -0.04580368961312479f : h == 1 ? -0.02272007650008353f : h == 2 ? -0.011315313227834146f : -0.005646563141142062f; }
__device__ __forceinline__ bf16x8 lds_frag(const LAS bf16* p) { return *(const LAS bf16x8*)p; }
#define MFMA16(a, b, c) __builtin_amdgcn_mfma_f32_16x16x32_bf16((a), (b), (c), 0, 0, 0)

__device__ __forceinline__ void rope8(const v4u a, const v4u b, const f32x4* rp4, float sc, float (&o1)[8], float (&o2)[8]) {
    const unsigned aw[4] = {a.x, a.y, a.z, a.w}, bw[4] = {b.x, b.y, b.z, b.w};
#pragma unroll
    for (int j = 0; j < 4; ++j) {
        const f32x4 cs = rp4[j];
        const float t1a = bflo(aw[j]), t1b = bfhi(aw[j]), t2a = bflo(bw[j]), t2b = bfhi(bw[j]);
        o1[2 * j] = (t1a * cs.x - t2a * cs.y) * sc; o2[2 * j] = (t1a * cs.y + t2a * cs.x) * sc;
        o1[2 * j + 1] = (t1b * cs.z - t2b * cs.w) * sc; o2[2 * j + 1] = (t1b * cs.w + t2b * cs.z) * sc;
    }
}

constexpr int KT_LD = 136, P2_KT = 0, P2_VT = 64 * KT_LD * 2;
struct P2Regs { v4u ka, kb; f32x4 rp[4]; v4u vv[4]; };
__device__ __forceinline__ void p2_state_load(Frame& F, int item, P2Regs& R) {
    const int h = item & 3, c = (item >> 2) & 31, b = item >> 7, t0 = b * SEQ + c * RC, m = F.tid & 127, q = F.tid >> 7;
    const bf16* krow = F.KH + ((size_t)item * 128 + m) * RDK;
    R.ka = *(const v4u*)(krow + q * 8); R.kb = *(const v4u*)(krow + 32 + q * 8);
    const f32x4* rp4 = (const f32x4*)(F.ROPE + (size_t)(c * RC + m) * 32 + q * 8);
#pragma unroll
    for (int j = 0; j < 4; ++j) R.rp[j] = rp4[j];
    const bf16* vrow = F.VH + ((size_t)item * 128 + m) * RDV + q * 32;
#pragma unroll
    for (int i = 0; i < 4; ++i) R.vv[i] = *(const v4u*)(vrow + i * 8);
}
__device__ __forceinline__ void p2_state_stage(Frame& F, int item, const P2Regs& R) {
    const int h = item & 3, m = F.tid & 127, q = F.tid >> 7;
    LAS bf16* KT = (LAS bf16*)(F.lds + P2_KT); LAS bf16* VT = (LAS bf16*)(F.lds + P2_VT);
    float o1[8], o2[8];
    rope8(R.ka, R.kb, R.rp, 0.125f * __builtin_amdgcn_exp2f(lg2_gamma(h) * (float)(127 - m)), o1, o2);
#pragma unroll
    for (int j = 0; j < 8; ++j) { KT[(q * 8 + j) * KT_LD + m] = (bf16)f2bf(o1[j]); KT[(q * 8 + j + 32) * KT_LD + m] = (bf16)f2bf(o2[j]); }
#pragma unroll
    for (int i = 0; i < 4; ++i) { const unsigned vw[4] = {R.vv[i].x, R.vv[i].y, R.vv[i].z, R.vv[i].w};
#pragma unroll
        for (int j = 0; j < 4; ++j) { VT[(q * 32 + i * 8 + 2 * j) * KT_LD + m] = (bf16)(vw[j] & 0xffffu); VT[(q * 32 + i * 8 + 2 * j + 1) * KT_LD + m] = (bf16)(vw[j] >> 16); } }
}
__device__ __forceinline__ void p2_state_compute(Frame& F, int item) {
    LAS bf16* KT = (LAS bf16*)(F.lds + P2_KT); LAS bf16* VT = (LAS bf16*)(F.lds + P2_VT);
    {
        const int w = F.wave, fr = F.lane & 15, fq = F.lane >> 4;
        f32x4 acc[4];
#pragma unroll
        for (int i = 0; i < 4; ++i) acc[i] = (f32x4){0.f, 0.f, 0.f, 0.f};
#pragma unroll
        for (int kk = 0; kk < 4; ++kk) {
            const bf16x8 bfrag = lds_frag(VT + (w * 16 + fr) * KT_LD + kk * 32 + fq * 8);
#pragma unroll
            for (int dkt = 0; dkt < 4; ++dkt) { const bf16x8 afrag = lds_frag(KT + (dkt * 16 + fr) * KT_LD + kk * 32 + fq * 8); acc[dkt] = MFMA16(afrag, bfrag, acc[dkt]); }
        }
        bf16* sp = F.S + (size_t)item * (RDV * RDK) + (size_t)(w * 16 + fr) * RDK + fq * 4;
#pragma unroll
        for (int dkt = 0; dkt < 4; ++dkt) { v2u o; o.x = pk2(acc[dkt][0], acc[dkt][1]); o.y = pk2(acc[dkt][2], acc[dkt][3]); *(v2u*)(sp + dkt * 16) = o; }
    }
}

constexpr int CV_TOK = 64, CV_ROWS = CV_TOK + CK - 1, P2_CT = 0, P2_YT = CV_ROWS * CCH * 2;
static_assert(P2_YT + 16 * CCH * 4 <= RING_BYTES, "conv LDS");
__device__ __forceinline__ void p2_conv_item(Frame& F, int ct) {
    const int t0 = ct * CV_TOK, s0 = t0 % SEQ;
    LAS bf16* CT = (LAS bf16*)(F.lds + P2_CT); LAS float* YT = (LAS float*)(F.lds + P2_YT);
    {
        constexpr int NIT = (CV_ROWS * (CCH / 8) + NWAVES * 64 - 1) / (NWAVES * 64);
        v4u uv[NIT], ug[NIT];
#pragma unroll
        for (int i = 0; i < NIT; ++i) {
            const int e = F.tid + i * NWAVES * 64, r = e >> 6, cg = e & 63;
            uv[i] = (v4u){0u, 0u, 0u, 0u}; ug[i] = (v4u){0u, 0u, 0u, 0u};
            if (e < CV_ROWS * (CCH / 8) && s0 + r - (CK - 1) >= 0) {
                const bf16* prow = F.PROJ + (size_t)(t0 + r - (CK - 1)) * NUVG;
                uv[i] = *(const v4u*)(prow + C_UV + cg * 8); ug[i] = *(const v4u*)(prow + C_UG + cg * 8);
            }
        }
#pragma unroll
        for (int i = 0; i < NIT; ++i) {
            const int e = F.tid + i * NWAVES * 64, r = e >> 6, cg = e & 63;
            if (e < CV_ROWS * (CCH / 8)) {
                v4u o;
                o.x = pk2(bflo(uv[i].x) * sigm(bflo(ug[i].x)), bfhi(uv[i].x) * sigm(bfhi(ug[i].x)));
                o.y = pk2(bflo(uv[i].y) * sigm(bflo(ug[i].y)), bfhi(uv[i].y) * sigm(bfhi(ug[i].y)));
                o.z = pk2(bflo(uv[i].z) * sigm(bflo(ug[i].z)), bfhi(uv[i].z) * sigm(bfhi(ug[i].z)));
                o.w = pk2(bflo(uv[i].w) * sigm(bflo(ug[i].w)), bfhi(uv[i].w) * sigm(bfhi(ug[i].w)));
                *(LAS v4u*)(CT + r * CCH + cg * 8) = o;
            }
        }
    }
    const int ch = F.tid;
    float wt[CK];
#pragma unroll
    for (int j = 0; j < CK; ++j) wt[j] = F.conv_dw_w[j * CCH + ch];
    const float bias = F.conv_dw_b[ch];
    __syncthreads();
    for (int st = 0; st < CV_TOK / 16; ++st) {
        float win[16 + CK - 1];
#pragma unroll
        for (int r = 0; r < 16 + CK - 1; ++r) win[r] = bf1(CT[(st * 16 + r) * CCH + ch]);
#pragma unroll
        for (int i = 0; i < 16; ++i) { float y = bias;
#pragma unroll
            for (int j = 0; j < CK; ++j) y += win[i + j] * wt[j];
            YT[i * CCH + ch] = y; }
        __syncthreads();
#pragma unroll
        for (int rr = 0; rr < 2; ++rr) {
            const int i = F.wave + rr * 8;
            const f32x4 a = *(const LAS f32x4*)(YT + i * CCH + F.lane * 8), b2 = *(const LAS f32x4*)(YT + i * CCH + F.lane * 8 + 4);
            const float mean = wave_sum_dpp((a.x + a.y) + (a.z + a.w) + (b2.x + b2.y) + (b2.z + b2.w)) * (1.f / CCH);
            const f32x4 da = a - mean, db = b2 - mean;
            const float var = wave_sum_dpp((da.x * da.x + da.y * da.y) + (da.z * da.z + da.w * da.w) + (db.x * db.x + db.y * db.y) + (db.z * db.z + db.w * db.w)) * (1.f / CCH);
            const float rstd = 1.f / sqrtf(var + LN_EPS);
            const f32x4 g0 = *(const f32x4*)(F.conv_ln_g + F.lane * 8), g1 = *(const f32x4*)(F.conv_ln_g + F.lane * 8 + 4);
            const f32x4 e0 = *(const f32x4*)(F.conv_ln_b + F.lane * 8), e1 = *(const f32x4*)(F.conv_ln_b + F.lane * 8 + 4);
            f32x4 y0 = da * rstd * g0 + e0, y1 = db * rstd * g1 + e1;
            y0.x *= sigm(y0.x); y0.y *= sigm(y0.y); y0.z *= sigm(y0.z); y0.w *= sigm(y0.w);
            y1.x *= sigm(y1.x); y1.y *= sigm(y1.y); y1.z *= sigm(y1.z); y1.w *= sigm(y1.w);
            v4u o; o.x = pk2(y0.x, y0.y); o.y = pk2(y0.z, y0.w); o.z = pk2(y1.x, y1.y); o.w = pk2(y1.z, y1.w);
            *(v4u*)(F.CB + (size_t)(t0 + st * 16 + i) * CCH + F.lane * 8) = o;
        }
        __syncthreads();
    }
}

__device__ __forceinline__ void p3_scan(Frame& F) {
    const int NT = F.G * NWAVES * 64, gt = F.vcu * (NWAVES * 64) + F.tid;
    constexpr int PER = RDV * RDK / 2;
    for (int e = gt; e < BATCH * RH * PER; e += NT) {
        const int p = e % PER, h = (e / PER) & 3, b = e / (PER * RH);
        const float dec = __builtin_amdgcn_exp2f(lg2_gamma(h) * 128.0f);
        unsigned* sp = (unsigned*)F.S + ((size_t)(b * NCH) * RH + h) * PER + p;
        unsigned v[NCH];
#pragma unroll
        for (int c = 0; c < NCH; ++c) v[c] = sp[(size_t)c * RH * PER];
        float s0 = 0.f, s1 = 0.f;
#pragma unroll
        for (int c = 0; c < NCH; ++c) { sp[(size_t)c * RH * PER] = pk2(s0, s1); s0 = s0 * dec + bflo(v[c]); s1 = s1 * dec + bfhi(v[c]); }
    }
}

constexpr int QK_LD = 72, P4_QS = 0, P4_KS = P4_QS + 128 * QK_LD * 2, P4_VT = P4_KS + 128 * QK_LD * 2, P4_ST = P4_VT + 128 * KT_LD * 2, P4_PS = P4_ST + 128 * QK_LD * 2, P4_END = P4_PS + 128 * KT_LD * 2;
static_assert(P4_END <= RING_BYTES, "P4 LDS");
struct P4Regs { v4u qa, qb, ka, kb; f32x4 rp[4]; v4u vv[4]; v4u st[2]; v4u g[4]; };
__device__ __forceinline__ void p4_load(Frame& F, int item, P4Regs& R) {
    const int h = item & 3, c = (item >> 2) & 31, b = item >> 7, t0 = b * SEQ + c * RC, m = F.tid & 127, q = F.tid >> 7;
    const bf16* qrow = F.QH + ((size_t)item * 128 + m) * RDK; const bf16* krow = F.KH + ((size_t)item * 128 + m) * RDK;
    R.qa = *(const v4u*)(qrow + q * 8); R.qb = *(const v4u*)(qrow + 32 + q * 8);
    R.ka = *(const v4u*)(krow + q * 8); R.kb = *(const v4u*)(krow + 32 + q * 8);
    const f32x4* rp4 = (const f32x4*)(F.ROPE + (size_t)(c * RC + m) * 32 + q * 8);
#pragma unroll
    for (int j = 0; j < 4; ++j) R.rp[j] = rp4[j];
    const bf16* vrow = F.VH + ((size_t)item * 128 + m) * RDV + q * 32;
#pragma unroll
    for (int i = 0; i < 4; ++i) R.vv[i] = *(const v4u*)(vrow + i * 8);
    const bf16* sp = F.S + (size_t)item * (RDV * RDK);
#pragma unroll
    for (int i = 0; i < 2; ++i) { const int pc = F.tid + i * 512, dv = pc >> 3, d8 = pc & 7; R.st[i] = *(const v4u*)(sp + dv * RDK + d8 * 8); }
    { const int n = F.wave * 16 + (F.lane >> 2), d0 = (F.lane & 3) * 32; const bf16* grow = F.GH + ((size_t)item * 128 + n) * RDV + d0;
#pragma unroll
      for (int i = 0; i < 4; ++i) R.g[i] = *(const v4u*)(grow + i * 8); }
}
__device__ __forceinline__ void p4_stage(Frame& F, int item, const P4Regs& R) {
    const int h = item & 3;
    LAS bf16* QS = (LAS bf16*)(F.lds + P4_QS); LAS bf16* KS = (LAS bf16*)(F.lds + P4_KS); LAS bf16* VT = (LAS bf16*)(F.lds + P4_VT); LAS bf16* ST = (LAS bf16*)(F.lds + P4_ST);
    const float lg = lg2_gamma(h);
    const int m = F.tid & 127, q = F.tid >> 7;
    float o1[8], o2[8];
    {
        rope8(R.qa, R.qb, R.rp, __builtin_amdgcn_exp2f(lg * (float)(m + 1)), o1, o2);
        v4u w1, w2; w1.x = pk2(o1[0], o1[1]); w1.y = pk2(o1[2], o1[3]); w1.z = pk2(o1[4], o1[5]); w1.w = pk2(o1[6], o1[7]);
        w2.x = pk2(o2[0], o2[1]); w2.y = pk2(o2[2], o2[3]); w2.z = pk2(o2[4], o2[5]); w2.w = pk2(o2[6], o2[7]);
        *(LAS v4u*)(QS + m * QK_LD + q * 8) = w1; *(LAS v4u*)(QS + m * QK_LD + 32 + q * 8) = w2;
    }
    {
        rope8(R.ka, R.kb, R.rp, 0.125f * __builtin_amdgcn_exp2f(-lg * (float)(m + 1)), o1, o2);
        v4u w1, w2; w1.x = pk2(o1[0], o1[1]); w1.y = pk2(o1[2], o1[3]); w1.z = pk2(o1[4], o1[5]); w1.w = pk2(o1[6], o1[7]);
        w2.x = pk2(o2[0], o2[1]); w2.y = pk2(o2[2], o2[3]); w2.z = pk2(o2[4], o2[5]); w2.w = pk2(o2[6], o2[7]);
        *(LAS v4u*)(KS + m * QK_LD + q * 8) = w1; *(LAS v4u*)(KS + m * QK_LD + 32 + q * 8) = w2;
    }
#pragma unroll
    for (int i = 0; i < 4; ++i) { const unsigned vw[4] = {R.vv[i].x, R.vv[i].y, R.vv[i].z, R.vv[i].w};
#pragma unroll
        for (int j = 0; j < 4; ++j) { VT[(q * 32 + i * 8 + 2 * j) * KT_LD + m] = (bf16)(vw[j] & 0xffffu); VT[(q * 32 + i * 8 + 2 * j + 1) * KT_LD + m] = (bf16)(vw[j] >> 16); } }
#pragma unroll
    for (int i = 0; i < 2; ++i) { const int pc = F.tid + i * 512, dv = pc >> 3, d8 = pc & 7; *(LAS v4u*)(ST + dv * QK_LD + d8 * 8) = R.st[i]; }
}
__device__ __forceinline__ void p4_compute(Frame& F, int item, const v4u (&gpre)[4]) {
    const int h = item & 3, c = (item >> 2) & 31, b = item >> 7;
    const int t0 = b * SEQ + c * RC;
    LAS bf16* QS = (LAS bf16*)(F.lds + P4_QS); LAS bf16* KS = (LAS bf16*)(F.lds + P4_KS); LAS bf16* VT = (LAS bf16*)(F.lds + P4_VT);
    LAS bf16* ST = (LAS bf16*)(F.lds + P4_ST); LAS bf16* PS = (LAS bf16*)(F.lds + P4_PS);
    const int w = F.wave, fr = F.lane & 15, fq = F.lane >> 4;
    const int nkk = (w >> 1) + 1;
    {
        const bf16x8 qa0 = lds_frag(QS + (w * 16 + fr) * QK_LD + fq * 8), qa1 = lds_frag(QS + (w * 16 + fr) * QK_LD + 32 + fq * 8);
        for (int jt = 0; jt < 2 * nkk; ++jt) {
            f32x4 s = (f32x4){0.f, 0.f, 0.f, 0.f};
            if (jt <= w) {
                const bf16x8 kb0 = lds_frag(KS + (jt * 16 + fr) * QK_LD + fq * 8), kb1 = lds_frag(KS + (jt * 16 + fr) * QK_LD + 32 + fq * 8);
                s = MFMA16(qa0, kb0, s); s = MFMA16(qa1, kb1, s);
            }
            const int mcol = jt * 16 + fr;
#pragma unroll
            for (int r = 0; r < 4; ++r) { const int n = w * 16 + fq * 4 + r; PS[n * KT_LD + mcol] = (bf16)f2bf(n >= mcol ? s[r] : 0.f); }
        }
    }
    __syncthreads();
    f32x4 o[8];
    {
        const bf16x8 qa0 = lds_frag(QS + (w * 16 + fr) * QK_LD + fq * 8), qa1 = lds_frag(QS + (w * 16 + fr) * QK_LD + 32 + fq * 8);
#pragma unroll
        for (int jt = 0; jt < 8; ++jt) {
            f32x4 a = (f32x4){0.f, 0.f, 0.f, 0.f};
            a = MFMA16(qa0, lds_frag(ST + (jt * 16 + fr) * QK_LD + fq * 8), a);
            a = MFMA16(qa1, lds_frag(ST + (jt * 16 + fr) * QK_LD + 32 + fq * 8), a);
            for (int kk = 0; kk < nkk; ++kk) a = MFMA16(lds_frag(PS + (w * 16 + fr) * KT_LD + kk * 32 + fq * 8), lds_frag(VT + (jt * 16 + fr) * KT_LD + kk * 32 + fq * 8), a);
            o[jt] = a;
        }
    }
    float mean[4], rstd[4];
#pragma unroll
    for (int r = 0; r < 4; ++r) {
        float s = 0.f;
#pragma unroll
        for (int jt = 0; jt < 8; ++jt) s += o[jt][r];
        s = row16_sum(s);
        mean[r] = s * (1.f / RDV);
        float q2 = 0.f;
#pragma unroll
        for (int jt = 0; jt < 8; ++jt) { const float d = o[jt][r] - mean[r]; q2 += d * d; }
        q2 = row16_sum(q2);
        rstd[r] = 1.f / sqrtf(q2 * (1.f / RDV) + LN_EPS);
    }
    __syncthreads();
#pragma unroll
    for (int jt = 0; jt < 8; ++jt) { const float gg = F.ret_gn_g[h * RDV + jt * 16 + fr];
#pragma unroll
        for (int r = 0; r < 4; ++r) PS[(w * 16 + fq * 4 + r) * KT_LD + jt * 16 + fr] = (bf16)f2bf((o[jt][r] - mean[r]) * rstd[r] * gg); }
    __syncthreads();
    {
        const int n = w * 16 + (F.lane >> 2), d0 = (F.lane & 3) * 32;
        bf16* orow = F.RA + (size_t)(t0 + n) * RW + h * RDV + d0;
#pragma unroll
        for (int i = 0; i < 4; ++i) {
            const v4u y = *(const LAS v4u*)(PS + n * KT_LD + d0 + i * 8); const v4u g = gpre[i];
            const unsigned yw[4] = {y.x, y.y, y.z, y.w}, gw[4] = {g.x, g.y, g.z, g.w}; unsigned ow[4];
#pragma unroll
            for (int j = 0; j < 4; ++j) { const float ga = bflo(gw[j]), gb = bfhi(gw[j]); ow[j] = pk2(bflo(yw[j]) * ga * sigm(ga), bfhi(yw[j]) * gb * sigm(gb)); }
            *(v4u*)(orow + i * 8) = (v4u){ow[0], ow[1], ow[2], ow[3]};
        }
    }
    __syncthreads();
}

#if DBG_PROBE
__device__ __forceinline__ void dbg_probe(Frame& F, int stage) {
    const int gw = F.vcu * NWAVES + F.wave, NGW = F.G * NWAVES;
    for (int m = gw; m < M; m += NGW) {
        const size_t t = (size_t)m; const int lane = F.lane; bool bad = false;
        const int cls = (int)(t & 7);
        const void* prow = nullptr; int nvec = 0; int mode = 0;
        if (cls == 1) { prow = F.ROPE + (t % SEQ) * 32; nvec = 16; mode = 1; }
        else if (cls == 2 || cls == 3) { prow = F.S + (t >> 5) * 8192; nvec = 1024; }
        else if (cls >= 4) { prow = F.PROJ + t * NIN; nvec = 1536 / 8; mode = 2; }
        for (int i = lane; i < nvec; i += 64) { const v4u w = ((const v4u*)prow)[i]; const unsigned ww[4] = {w.x, w.y, w.z, w.w};
#pragma unroll
            for (int j = 0; j < 4; ++j) {
                if (mode == 0) bad |= ((ww[j] & 0x7f80u) == 0x7f80u) | ((ww[j] & 0x7f800000u) == 0x7f800000u);
                else if (mode == 1) bad |= ((ww[j] & 0x7f800000u) == 0x7f800000u);
                else bad |= ((ww[j] & 0x7f80u) >= (133u << 7)) | ((ww[j] & 0x7f800000u) >= (133u << 23)); } }
        bad = __any(bad);
        if (lane == 0) ((unsigned*)((unsigned char*)F.UT - 1 * MiB))[t] = bad ? 1u : 0u;
    }
}
#endif
constexpr int P9_VR = DBG_P9_VR;
constexpr int P9_TOK = 64, P9_IDX = 0, P9_CQ = P9_IDX + 128 * 128 * 2, P9_CINV = P9_CQ + 128 * 128, P9_GU = P9_CINV + 512, P9_LUT = P9_GU + P9_TOK * 128 * 4, P9_ZP = P9_LUT  , P9_HROW = P9_ZP + P9_TOK * 128 * 4, P9_IMG = P9_GU, P9_IMG_BLK = 520, P9_IMG_W = 16 * P9_IMG_BLK,
              P9_GV = (P9_IMG + NWAVES * P9_IMG_W > P9_HROW + NWAVES * 512 ? P9_IMG + NWAVES * P9_IMG_W : P9_HROW + NWAVES * 512), P9_ZERO = P9_GV + 2 * D * 4, P9_END = P9_ZERO + 512;
static_assert(P9_END <= RING_BYTES && P9_LUT + 512 * 32 <= P9_HROW, "P9 LDS");
__device__ __forceinline__ unsigned mono16(unsigned hb) { return (hb & 0x8000u) ? (~hb & 0xffffu) : (hb | 0x8000u); }
__device__ __forceinline__ float unmono16(unsigned m) { const unsigned hb = (m & 0x8000u) ? (m & 0x7fffu) : (~m & 0xffffu); return (float)__builtin_bit_cast(_Float16, (unsigned short)hb); }
#define CE(a, b) do { const unsigned _h = (a) > (b) ? (a) : (b), _l = (a) > (b) ? (b) : (a); (a) = _h; (b) = _l; } while (0)
__device__ __forceinline__ void sort16_desc(unsigned (&K)[16]) {
    CE(K[0], K[1]); CE(K[2], K[3]); CE(K[0], K[2]); CE(K[1], K[3]); CE(K[1], K[2]); CE(K[4], K[5]);
    CE(K[6], K[7]); CE(K[4], K[6]); CE(K[5], K[7]); CE(K[5], K[6]); CE(K[0], K[4]); CE(K[2], K[6]);
    CE(K[2], K[4]); CE(K[1], K[5]); CE(K[3], K[7]); CE(K[3], K[5]); CE(K[1], K[2]); CE(K[3], K[4]);
    CE(K[5], K[6]); CE(K[8], K[9]); CE(K[10], K[11]); CE(K[8], K[10]); CE(K[9], K[11]); CE(K[9], K[10]);
    CE(K[12], K[13]); CE(K[14], K[15]); CE(K[12], K[14]); CE(K[13], K[15]); CE(K[13], K[14]); CE(K[8], K[12]);
    CE(K[10], K[14]); CE(K[10], K[12]); CE(K[9], K[13]); CE(K[11], K[15]); CE(K[11], K[13]); CE(K[9], K[10]);
    CE(K[11], K[12]); CE(K[13], K[14]); CE(K[0], K[8]); CE(K[4], K[12]); CE(K[4], K[8]); CE(K[2], K[10]);
    CE(K[6], K[14]); CE(K[6], K[10]); CE(K[2], K[4]); CE(K[6], K[8]); CE(K[10], K[12]); CE(K[1], K[9]);
    CE(K[5], K[13]); CE(K[5], K[9]); CE(K[3], K[11]); CE(K[7], K[15]); CE(K[7], K[11]); CE(K[3], K[5]);
    CE(K[7], K[9]); CE(K[11], K[13]); CE(K[1], K[2]); CE(K[3], K[4]); CE(K[5], K[6]); CE(K[7], K[8]);
    CE(K[9], K[10]); CE(K[11], K[12]); CE(K[13], K[14]);
}
__device__ __forceinline__ void merge16_desc(unsigned (&T)[16], const unsigned (&S)[16]) {
#pragma unroll
    for (int i = 0; i < 16; ++i) T[i] = T[i] > S[15 - i] ? T[i] : S[15 - i];
    CE(T[0], T[8]); CE(T[1], T[9]); CE(T[2], T[10]); CE(T[3], T[11]); CE(T[4], T[12]); CE(T[5], T[13]); CE(T[6], T[14]); CE(T[7], T[15]);
    CE(T[0], T[4]); CE(T[1], T[5]); CE(T[2], T[6]); CE(T[3], T[7]); CE(T[8], T[12]); CE(T[9], T[13]); CE(T[10], T[14]); CE(T[11], T[15]);
    CE(T[0], T[2]); CE(T[1], T[3]); CE(T[4], T[6]); CE(T[5], T[7]); CE(T[8], T[10]); CE(T[9], T[11]); CE(T[12], T[14]); CE(T[13], T[15]);
    CE(T[0], T[1]); CE(T[2], T[3]); CE(T[4], T[5]); CE(T[6], T[7]); CE(T[8], T[9]); CE(T[10], T[11]); CE(T[12], T[13]); CE(T[14], T[15]);
}
#undef CE
__device__ __forceinline__ void topk_lists(const unsigned short* s, unsigned (&L1)[16], unsigned (&L2)[16]) {
#pragma unroll
    for (int j = 0; j < 16; ++j) { L1[j] = 0u; L2[j] = 0u; }
    v4u w[4][2];
#pragma unroll
    for (int k = 0; k < 4; ++k) { w[k][0] = *(const v4u*)(s + k * 16); w[k][1] = *(const v4u*)(s + k * 16 + 8); }
#pragma unroll 1
    for (int o = 0; o < 2; ++o) {
#pragma unroll
        for (int k = 0; k < 4; ++k) { const int c = 4 * o + k;
            const unsigned ww[8] = {w[k][0].x, w[k][0].y, w[k][0].z, w[k][0].w, w[k][1].x, w[k][1].y, w[k][1].z, w[k][1].w};
            w[k][0] = *(const v4u*)(s + (c + 4) * 16); w[k][1] = *(const v4u*)(s + (c + 4) * 16 + 8);
            unsigned S[16];
#pragma unroll
            for (int e = 0; e < 16; ++e) { const unsigned hb = (ww[e >> 1] >> (16 * (e & 1))) & 0xffffu; S[e] = (mono16(hb) << 16) | (unsigned)(127 - (c * 16 + e)); }
            sort16_desc(S); merge16_desc(L1, S); }
    }
#pragma unroll 1
    for (int o = 0; o < 2; ++o) {
#pragma unroll
        for (int k = 0; k < 4; ++k) { const int c = 4 * o + k;
            const unsigned ww[8] = {w[k][0].x, w[k][0].y, w[k][0].z, w[k][0].w, w[k][1].x, w[k][1].y, w[k][1].z, w[k][1].w};
            if (o == 0) { w[k][0] = *(const v4u*)(s + 128 + (c + 4) * 16); w[k][1] = *(const v4u*)(s + 128 + (c + 4) * 16 + 8); }
            unsigned S[16];
#pragma unroll
            for (int e = 0; e < 16; ++e) { const unsigned hb = (ww[e >> 1] >> (16 * (e & 1))) & 0xffffu; S[e] = (mono16(hb) << 16) | (unsigned)(127 - (c * 16 + e)); }
            sort16_desc(S); merge16_desc(L2, S); }
    }
}
__device__ __forceinline__ unsigned msum(float f) { const unsigned u = __builtin_bit_cast(unsigned, f); return (u & 0x80000000u) ? ~u : (u | 0x80000000u); }
__device__ __forceinline__ float gelu_erf(float v) {
    const float av = __builtin_fabsf(v), t = __builtin_amdgcn_rcpf(av * 0.2316418882f + 1.0f);
    float q = t * 0.5307027145f + (-0.7265760135f); q = q * t + 0.7107068705f; q = q * t + (-0.142248368f); q = q * t + 0.127414796f; q = q * t;
    const float e = __builtin_amdgcn_exp2f((v * v) * (-0.72134752044f));
    const float m = v * (q * e);
    return v < 0.f ? m : v - m;
}
__device__ __forceinline__ void p9_topk(Frame& F, const size_t t0, const int lt0) {
    LAS unsigned short* IDXS = (LAS unsigned short*)(F.lds + P9_IDX) + lt0 * 128; LAS unsigned* GU = (LAS unsigned*)(F.lds + P9_GU); LAS _Float16* GUH = (LAS _Float16*)GU;
    {
        int tidv = F.tid; asm volatile("" : "+v"(tidv));
        const int tl = tidv >> 3, hd = tidv & 7;
        const unsigned short* srow = F.SC + (t0 + tl) * NSC + hd * PQ;
        unsigned L1[16], L2[16];
        topk_lists(srow, L1, L2);
        LAS unsigned* lut = (LAS unsigned*)(F.lds + P9_LUT) + tidv * 8;
        float v1[16], v2[16];
#pragma unroll
        for (int i = 0; i < 16; ++i) { v1[i] = unmono16(L1[i] >> 16); v2[i] = unmono16(L2[i] >> 16); }
#pragma unroll
        for (int i = 0; i < 4; ++i) {
            lut[i] = (127u - (L1[4 * i] & 0xffu)) | ((127u - (L1[4 * i + 1] & 0xffu)) << 8) | ((127u - (L1[4 * i + 2] & 0xffu)) << 16) | ((127u - (L1[4 * i + 3] & 0xffu)) << 24);
            lut[4 + i] = (127u - (L2[4 * i] & 0xffu)) | ((127u - (L2[4 * i + 1] & 0xffu)) << 8) | ((127u - (L2[4 * i + 2] & 0xffu)) << 16) | ((127u - (L2[4 * i + 3] & 0xffu)) << 24);
        }
        unsigned R[16];
#pragma unroll
        for (int j = 0; j < 16; ++j) R[j] = 0u;
#define CAND(i, j) ((msum(v1[i] + v2[j]) & 0xffffff00u) | (unsigned)(255 - ((i) * 16 + (j))))
        { unsigned S[16] = {CAND(0, 0), CAND(0, 1), CAND(0, 2), CAND(0, 3), CAND(0, 4), CAND(0, 5), CAND(0, 6), CAND(0, 7), CAND(0, 8), CAND(0, 9), CAND(0, 10), CAND(0, 11), CAND(0, 12), CAND(0, 13), CAND(0, 14), CAND(0, 15)}; sort16_desc(S); merge16_desc(R, S); }
        { unsigned S[16] = {CAND(1, 0), CAND(1, 1), CAND(1, 2), CAND(1, 3), CAND(1, 4), CAND(1, 5), CAND(1, 6), CAND(1, 7), CAND(2, 0), CAND(2, 1), CAND(2, 2), CAND(2, 3), CAND(2, 4), CAND(3, 0), CAND(3, 1), CAND(3, 2)}; sort16_desc(S); merge16_desc(R, S); }
        { unsigned S[16] = {CAND(3, 3), CAND(4, 0), CAND(4, 1), CAND(4, 2), CAND(5, 0), CAND(5, 1), CAND(6, 0), CAND(6, 1), CAND(7, 0), CAND(7, 1), CAND(8, 0), CAND(9, 0), CAND(10, 0), CAND(11, 0), CAND(12, 0), CAND(13, 0)}; sort16_desc(S); merge16_desc(R, S); }
        { unsigned S[16] = {CAND(14, 0), CAND(15, 0), 0u, 0u, 0u, 0u, 0u, 0u, 0u, 0u, 0u, 0u, 0u, 0u, 0u, 0u}; sort16_desc(S); merge16_desc(R, S); }
#undef CAND
        const LAS unsigned char* lb = (const LAS unsigned char*)lut;
        float wv[16], vs[16], wsum = 0.f, vmax = 0.f;
#pragma unroll
        for (int r = 0; r < 16; ++r) {
            const unsigned key = R[r], mk = key & 0xffffff00u;
            const float val = __builtin_bit_cast(float, (mk & 0x80000000u) ? (mk & 0x7fffffffu) : ~mk);
            if (r == 0) vmax = val;
            wv[r] = __builtin_amdgcn_exp2f((val - vmax) * 1.4426950408889634f); wsum += wv[r];
            const unsigned pos = 255u - (key & 0xffu);
            const unsigned e1 = lb[pos >> 4], e2 = lb[16 + (pos & 15u)], ex = e1 * 128u + e2;
            IDXS[tl * 128 + hd * 16 + r] = (unsigned short)ex;
            const unsigned uv = ((const unsigned*)F.USC)[ex];
            ((LAS unsigned short*)GUH)[2 * (tl * 128 + hd * 16 + r)] = (unsigned short)(uv & 0xffffu); vs[r] = (float)__builtin_bit_cast(_Float16, (unsigned short)(uv >> 16));
        }
        const float inv = 1.0f / wsum;
#pragma unroll
        for (int r = 0; r < 16; ++r) GUH[2 * (tl * 128 + hd * 16 + r) + 1] = (_Float16)(wv[r] * inv * vs[r]);
    }
}
#define P9_EM (DBG_DUMMY_EMASK != 0 ? emask : 0xffff)
typedef int p9v8i __attribute__((ext_vector_type(8)));
typedef int p9v4i __attribute__((ext_vector_type(4)));
typedef int p9v2i __attribute__((ext_vector_type(2)));
__device__ __forceinline__ void p9_dots8(Frame& F, const size_t t0, const int lt0, const int gt0, const int rnd, const int emask) {
    int lanev = F.lane; asm volatile("" : "+v"(lanev));
    const int lane = lanev, lq = lane >> 4, ln = lane & 15;
    const LAS unsigned short* IDXS = (const LAS unsigned short*)(F.lds + P9_IDX) + lt0 * 128; const LAS unsigned* GU = (const LAS unsigned*)(F.lds + P9_GU) + gt0 * 128;
    LAS float* ZP = (LAS float*)(F.lds + P9_ZP) + gt0 * 128;
    LAS unsigned char* CQ = F.lds + P9_CQ + lt0 * 128; LAS float* CINV = (LAS float*)(F.lds + P9_CINV) + lt0;
    LAS unsigned char* hrow = F.lds + P9_HROW + F.wave * 512;
    const LAS unsigned char* habase = (lq == (ln >> 2) ? hrow + 16 * (ln & 3) : F.lds + P9_ZERO) + rnd * 256;
    const int dim0 = 16 * ln + 4 * lq;
    const int ucol = rnd * 256 + (lane & 3) * 16;
    const int zslot = 4 * lq + (ln >> 2);
    unsigned char* H4 = F.XN8; float* HS = (float*)(F.XN8 + (size_t)M * 512);
    v2u hw[4] = {{0u, 0u}, {0u, 0u}, {0u, 0u}, {0u, 0u}}; float sst = 0.f; v2u hqn = {0u, 0u}; float hsn = 0.f; p9v4i buf[4][4];
    {
#pragma unroll
        for (int b = 0; b < 4; ++b) { const int uo = ((int)IDXS[16 * b + (lane >> 2)] & P9_EM) * D + ucol;
#pragma unroll
            for (int s2 = 0; s2 < 4; ++s2) buf[b][s2] = *(const p9v4i*)(F.UT + (size_t)(unsigned)uo + s2 * 64);
        }
        if (rnd == 0) {
#pragma unroll
            for (int G = 0; G < 4; ++G) hw[G] = *(const v2u*)(F.X1 + t0 * D + 256 * G + dim0);
            sst = F.SS[t0 * 16 + ln]; }
        else { hqn = *(const v2u*)(H4 + t0 * 512 + lane * 8); hsn = HS[t0]; }
    }
#pragma unroll 1
    for (int it = 0; it < 8; ++it) {
        const int itn = it < 7 ? it + 1 : it;
        float hs;
        if (rnd != 0) { *(LAS v2u*)(hrow + lane * 8) = hqn; hs = hsn; }
        else
        {
            float s16 = sst;
            s16 = row16_sum(s16);
            const float rstd = 1.0f / sqrtf(s16 * (1.f / D) + RMS_EPS);
            float hf[16], sq = 0.f;
#pragma unroll
            for (int G = 0; G < 4; ++G) { const f32x4 g = *(const LAS f32x4*)(F.lds + P9_GV + (256 * G + dim0) * 4);
                hf[4 * G] = bflo(hw[G].x) * g.x * rstd; hf[4 * G + 1] = bfhi(hw[G].x) * g.y * rstd; hf[4 * G + 2] = bflo(hw[G].y) * g.z * rstd; hf[4 * G + 3] = bfhi(hw[G].y) * g.w * rstd;
                sq += (hf[4 * G] * hf[4 * G] + hf[4 * G + 1] * hf[4 * G + 1]) + (hf[4 * G + 2] * hf[4 * G + 2] + hf[4 * G + 3] * hf[4 * G + 3]); }
            const float hr = sqrtf(wave_sum_dpp(sq) * (1.f / D));
            const float qi = hr > 0.f ? 2.0f / hr : 0.f; hs = hr * 0.5f;
#pragma unroll
            for (int G = 0; G < 4; ++G) { unsigned p = 0u;
                p = __builtin_amdgcn_cvt_scalef32_pk_fp4_f32(p, hf[4 * G] * qi, hf[4 * G + 1] * qi, 1.0f, 0); p = __builtin_amdgcn_cvt_scalef32_pk_fp4_f32(p, hf[4 * G + 2] * qi, hf[4 * G + 3] * qi, 1.0f, 1);
                *(LAS unsigned short*)(hrow + 128 * G + (dim0 >> 1)) = (unsigned short)p; }
            *(v2u*)(H4 + (t0 + it) * 512 + lane * 8) = *(const LAS v2u*)(hrow + lane * 8); if (lane == 0) HS[t0 + it] = hs;
        }
        p9v4i hA[4];
#pragma unroll
        for (int s2 = 0; s2 < 4; ++s2) hA[s2] = *(const LAS p9v4i*)(habase + s2 * 64);
        float cval[8];
#pragma unroll
        for (int s = 0; s < 8; ++s) {
            const int bs = s & 3;
            {
                f32x4 zc = (f32x4){0.f, 0.f, 0.f, 0.f};
#pragma unroll
                for (int s2 = 0; s2 < 4; ++s2) {
                    const p9v8i tb = {buf[bs][s2].x, buf[bs][s2].y, buf[bs][s2].z, buf[bs][s2].w, 0, 0, 0, 0};
                    const p9v8i aa = {hA[s2].x, hA[s2].y, hA[s2].z, hA[s2].w, 0, 0, 0, 0};
                    zc = __builtin_amdgcn_mfma_scale_f32_16x16x128_f8f6f4(aa, tb, zc, 4, 4, 0, 0x7f7f7f7f, 0, 0x7f7f7f7f);
                }
                const int r = ln & 3; float zsel = r == 0 ? zc[0] : r == 1 ? zc[1] : r == 2 ? zc[2] : zc[3];
                zsel = quad_sum(zsel);
                if (rnd == 0) { if ((ln & 3) == 0) ZP[it * 128 + 16 * s + zslot] = zsel; cval[s] = 0.f; }
                else {
                    zsel += ZP[it * 128 + 16 * s + zslot];
                    const unsigned gu = GU[it * 128 + 16 * s + zslot];
                    const float usc = (float)__builtin_bit_cast(_Float16, (unsigned short)(gu & 0xffffu)), gv = (float)__builtin_bit_cast(_Float16, (unsigned short)(gu >> 16));
                    cval[s] = gelu_erf(zsel * hs * usc) * gv;
                }
            }
            { const int uo = ((int)IDXS[(s + 4 < 8 ? it : itn) * 128 + 16 * ((s + 4) & 7) + (lane >> 2)] & P9_EM) * D + ucol;
#pragma unroll
                for (int s2 = 0; s2 < 4; ++s2) buf[bs][s2] = *(const p9v4i*)(F.UT + (size_t)(unsigned)uo + s2 * 64);
            }
            if (s == 3) {
                if (rnd == 0) {
#pragma unroll
                    for (int G = 0; G < 4; ++G) hw[G] = *(const v2u*)(F.X1 + (t0 + itn) * D + 256 * G + dim0);
                    sst = F.SS[(t0 + itn) * 16 + ln]; }
                else { hqn = *(const v2u*)(H4 + (t0 + itn) * 512 + lane * 8); hsn = HS[t0 + itn]; }
            }
        }
        if (rnd != 0) {
            float cm = 0.f;
#pragma unroll
            for (int g = 0; g < 8; ++g) cm = fmaxf(cm, __builtin_fabsf(cval[g]));
            cm = wave_max_dpp(cm);
            const float cq = cm > 0.f ? 256.0f / cm : 0.f;
            v2u cw;
            { int p = __builtin_amdgcn_cvt_pk_fp8_f32(cval[0] * cq, cval[1] * cq, 0, false); p = __builtin_amdgcn_cvt_pk_fp8_f32(cval[2] * cq, cval[3] * cq, p, true); cw.x = (unsigned)p; }
            { int p = __builtin_amdgcn_cvt_pk_fp8_f32(cval[4] * cq, cval[5] * cq, 0, false); p = __builtin_amdgcn_cvt_pk_fp8_f32(cval[6] * cq, cval[7] * cq, p, true); cw.y = (unsigned)p; }
            if ((ln & 3) == 0) *(LAS v2u*)(CQ + it * 128 + (4 * lq + (ln >> 2)) * 8) = cw;
            if (lane == 0) CINV[it] = cm * (1.0f / 256.0f);
        }
    }
}
template <int NR  > __device__ __forceinline__ void p9_vsum8(Frame& F, const size_t t0, const int lt0, const int hf  , const int emask, const bool dummy) {
    constexpr int SPT = 8 / NR, NP = 4 / NR;
    int lanev = F.lane; asm volatile("" : "+v"(lanev));
    const int lane = lanev, lq = lane >> 4, ln = lane & 15;
    const LAS unsigned short* IDXS = (const LAS unsigned short*)(F.lds + P9_IDX) + lt0 * 128;
    const LAS unsigned char* CQ = F.lds + P9_CQ + lt0 * 128; const LAS float* CINV = (const LAS float*)(F.lds + P9_CINV) + lt0;
    LAS unsigned char* img = F.lds + P9_IMG + F.wave * P9_IMG_W;
    LAS unsigned char* wbase = img + (2 * (lane & 7)) * P9_IMG_BLK + (lane >> 3) * 8;
    LAS unsigned char* rbase = img + lane * 8;
    const int dim0 = 16 * ln + 4 * lq;
    const int vslot0 = 16 * ((lane >> 3) & 7);
    const int vcol = D / 2 + hf * (512 / NR) + (lane & 7) * 16;
    int scl[4];
#pragma unroll
    for (int m = 0; m < 4; ++m) scl[m] = (ln >> 2) == m ? (0x7f << (8 * (ln & 3))) : 0;
    p9v4i buf[2][8]; v2u hwc[4];
#pragma unroll
    for (int b = 0; b < 2; ++b) {
#pragma unroll
        for (int i = 0; i < 8; ++i) { const int vo = ((int)IDXS[vslot0 + 4 * (i >> 1) + 2 * b + (i & 1)] & P9_EM) * D + vcol;
            buf[b][i] = *(const p9v4i*)(F.UT + (size_t)(unsigned)vo); }
    }
#pragma unroll 1
    for (int it = 0; it < 8; ++it) {
        const int itn = it < 7 ? it + 1 : it; const size_t t = t0 + it;
        const p9v4i cb0 = *(const LAS p9v4i*)(CQ + it * 128 + 16 * lq), cb1 = *(const LAS p9v4i*)(CQ + it * 128 + 64 + 16 * lq);
        const p9v8i cb = {cb0.x, cb0.y, cb0.z, cb0.w, cb1.x, cb1.y, cb1.z, cb1.w};
        const float cinv = CINV[it];
        f32x4 acc[NP]; p9v2i trA[16];
#pragma unroll
        for (int G = 0; G < NP; ++G) acc[G] = (f32x4){0.f, 0.f, 0.f, 0.f};
#pragma unroll
        for (int s = 0; s < SPT; ++s) {
            const int bs = s & 1;
#pragma unroll
            for (int i = 0; i < 8; ++i) {
                *(LAS p9v2i*)(wbase + 64 * i) = (p9v2i){buf[bs][i].x, buf[bs][i].y};
                *(LAS p9v2i*)(wbase + P9_IMG_BLK + 64 * i) = (p9v2i){buf[bs][i].z, buf[bs][i].w};
            }
            { const int vs = (s + 2) % SPT, tk = s + 2 < SPT ? it : itn;
#pragma unroll
                for (int i = 0; i < 8; ++i) { const int vo = ((int)IDXS[tk * 128 + vslot0 + 4 * (i >> 1) + 2 * (vs & 1) + (i & 1)] & P9_EM) * D + vcol + (vs >> 1) * 128;
                    buf[bs][i] = *(const p9v4i*)(F.UT + (size_t)(unsigned)vo); }
            }
            if (s == 1) {
#pragma unroll
                for (int G = 0; G < 4; ++G) hwc[G] = *(const v2u*)(F.X1 + t * D + 256 * G + dim0);
            }
            const int Pl = s >> 1;
            if ((s & 1) == 0) {
#pragma unroll
                for (int bb = 0; bb < 16; ++bb) trA[bb] = __builtin_amdgcn_ds_read_tr4_b64_v2i32((LAS p9v2i*)(rbase + bb * P9_IMG_BLK));
            } else {
                p9v2i trB[16];
#pragma unroll
                for (int bb = 0; bb < 16; ++bb) trB[bb] = __builtin_amdgcn_ds_read_tr4_b64_v2i32((LAS p9v2i*)(rbase + bb * P9_IMG_BLK));
#define P9_VBLK(bb, OPS) { const p9v8i aa = {trA[bb].x, trA[bb].y, trB[bb].x, trB[bb].y, 0, 0, 0, 0}; \
                acc[Pl] = __builtin_amdgcn_mfma_scale_f32_16x16x128_f8f6f4(aa, cb, acc[Pl], 4, 0, 0, 0x7f7f7f7f, OPS, scl[(bb) >> 2]); }
                P9_VBLK(0, 0) P9_VBLK(1, 1) P9_VBLK(2, 2) P9_VBLK(3, 3) P9_VBLK(4, 0) P9_VBLK(5, 1) P9_VBLK(6, 2) P9_VBLK(7, 3)
                P9_VBLK(8, 0) P9_VBLK(9, 1) P9_VBLK(10, 2) P9_VBLK(11, 3) P9_VBLK(12, 0) P9_VBLK(13, 1) P9_VBLK(14, 2) P9_VBLK(15, 3)
#undef P9_VBLK
            }
        }
        f32x4 r[4];
#pragma unroll
        for (int G = 0; G < 4; ++G) r[G] = (f32x4){bflo(hwc[G].x), bfhi(hwc[G].x), bflo(hwc[G].y), bfhi(hwc[G].y)};
        if (hf < NR - 1) {
#pragma unroll
            for (int Pl = 0; Pl < NP; ++Pl) { f32x4 y;
                if (NP == 1) y = hf == 0 ? r[0] : hf == 1 ? r[1] : r[2]; else y = r[Pl];
#if DBG_OUT == 0
                y += acc[Pl] * cinv;
#endif
                v2u o; o.x = pk2(y.x, y.y); o.y = pk2(y.z, y.w); if (!dummy) *(v2u*)(F.X1 + t * D + 256 * (hf * NP + Pl) + dim0) = o; }
            continue;
        }
        float* orow = F.out + t * D;
        float ss = 0.f;
#pragma unroll
        for (int G = 0; G < 4; ++G) { const int off = 256 * G + dim0;
#if DBG_OUT == 0
            if (G >= 4 - NP) r[G] += acc[G - (4 - NP)] * cinv;
#endif
#if DBG_OUT == 1
            r[G] = *(const f32x4*)(F.x + t * D + off);
#endif
#if DBG_SAN
            r[G].x = (__builtin_fabsf(r[G].x) < 1e30f) ? r[G].x : 0.f; r[G].y = (__builtin_fabsf(r[G].y) < 1e30f) ? r[G].y : 0.f; r[G].z = (__builtin_fabsf(r[G].z) < 1e30f) ? r[G].z : 0.f; r[G].w = (__builtin_fabsf(r[G].w) < 1e30f) ? r[G].w : 0.f;
#endif
            ss += (r[G].x * r[G].x + r[G].y * r[G].y) + (r[G].z * r[G].z + r[G].w * r[G].w); }
        const float rstd = 1.f / sqrtf(wave_sum_dpp(ss) * (1.f / D) + RMS_EPS);
        if (dummy) { if (lane == 0) ((float*)((unsigned char*)F.SS + 4 * MiB))[t] = rstd; continue; }
#pragma unroll
        for (int G = 0; G < 4; ++G) { const int off = 256 * G + dim0; const f32x4 g = *(const LAS f32x4*)(F.lds + P9_GV + D * 4 + off * 4);
            *(f32x4*)(orow + off) = r[G] * rstd * g; }
    }
}
__device__ __forceinline__ void p9_phase(Frame& F, const int emask = 0x3fff, const bool dummy = false) {
    ((LAS f32x2*)(F.lds + P9_GV))[F.tid] = ((const f32x2*)F.rms_ffn_g)[F.tid]; ((LAS f32x2*)(F.lds + P9_GV + D * 4))[F.tid] = ((const f32x2*)F.rms_final_g)[F.tid];
    if (F.tid < 128) ((LAS unsigned*)(F.lds + P9_ZERO))[F.tid] = 0u;
    const int ntile = M / P9_TOK;
    for (int tile0 = F.vcu; tile0 < ntile; tile0 += 2 * F.G) {
        __syncthreads();
        for (int j = 0; j < 2; ++j) { const int tile = tile0 + j * F.G; if (tile >= ntile) break;
            p9_topk(F, (size_t)tile * P9_TOK, j * P9_TOK);
            __syncthreads();
            for (int rnd = 0; rnd < 2; ++rnd) p9_dots8(F, (size_t)tile * P9_TOK + F.wave * 8, j * P9_TOK + F.wave * 8, F.wave * 8, rnd, emask);
            __syncthreads();
        }
        for (int rnd = 0; rnd < P9_VR; ++rnd)
        for (int j = 0; j < 2; ++j) { const int tile = tile0 + j * F.G; if (tile >= ntile) break;
            p9_vsum8<P9_VR>(F, (size_t)tile * P9_TOK + F.wave * 8, j * P9_TOK + F.wave * 8, rnd, emask, dummy);
        }
    }
    __syncthreads();
}

struct Args { const float* in[18]; float* out; unsigned char* ws; int ph_lo, ph_hi; };
__global__ void __launch_bounds__(NWAVES * 64, 2) mk_fwd(Args args) {
    extern __shared__ __attribute__((aligned(16))) unsigned char lds[];
    Frame F;
    F.lds = (LAS unsigned char*)lds;
    F.MISC = (volatile LAS unsigned*)(F.lds + MISC_OFF);
    F.wave = __builtin_amdgcn_readfirstlane((int)threadIdx.x >> 6); F.lane = mk_lane(); F.tid = F.wave * 64 + F.lane;
    F.G = gridDim.x; { const int bx = blockIdx.x; F.vcu = (F.G % 8 == 0) ? (bx % 8) * (F.G / 8) + bx / 8 : bx; }
    unsigned char* ws = args.ws;
    F.ctl = (gu32*)(ws + WS_CTL);
    F.x = args.in[0]; F.rms_mix_g = args.in[1]; F.w_in = args.in[2]; F.ret_gn_g = args.in[3]; F.conv_dw_w = args.in[4]; F.conv_dw_b = args.in[5]; F.conv_ln_g = args.in[6]; F.conv_ln_b = args.in[7];
    F.w_ret_proj = args.in[8]; F.w_conv_proj = args.in[9]; F.b_conv_proj = args.in[10]; F.w_out = args.in[11]; F.rms_ffn_g = args.in[12]; F.w_query = args.in[13]; F.sub_keys = args.in[14];
    F.peer_u = args.in[15]; F.peer_v = args.in[16]; F.rms_final_g = args.in[17]; F.out = args.out;
    F.ROPE = (f32x2*)(ws + WS_ROPE); F.WinT = (bf16*)(ws + WS_WIN); F.WrT = (bf16*)(ws + WS_WR); F.WcT = (bf16*)(ws + WS_WC); F.WoT = (bf16*)(ws + WS_WO); F.WqT = (bf16*)(ws + WS_WQ);
    F.UT = ws + WS_UT; F.XN8 = ws + WS_XN8; F.WinT8 = ws + WS_WIN8; F.VT = ws + WS_VT; F.USC = (float*)(ws + WS_USC); F.VSC = (float*)(ws + WS_VSC); F.XN = (bf16*)(ws + WS_XN); F.PROJ = (bf16*)(ws + WS_PROJ); F.S = (bf16*)(ws + WS_S);
    F.RA = (bf16*)args.out; F.CB = (bf16*)args.out + (size_t)M * RW; F.VH = (bf16*)args.out + (size_t)2 * M * RW; F.GH = (bf16*)args.out + (size_t)3 * M * RW; F.QH = (bf16*)(ws + WS_QH); F.KH = (bf16*)(ws + WS_KH); F.GTA = (bf16*)(ws + WS_GTA); F.GTB = (bf16*)(ws + WS_GTB); F.SC = (unsigned short*)(ws + WS_SC); F.X1 = (bf16*)(ws + WS_X1); F.SS = (float*)(ws + WS_SS);
    for (int u = F.tid; u < (LDS_BYTES - LDSCTL_OFF) / 4; u += NWAVES * 64) ((LAS unsigned*)(F.lds + LDSCTL_OFF))[u] = 0u;
    __syncthreads();
    XcdBarrier bar; bar.bar = (unsigned*)(F.ctl + CW_BAR); bar.x = 0; bar.st = nullptr;
    if (!MK_PER_PHASE) bar = xcd_barrier_post((unsigned*)(F.ctl + CW_BAR), F.MISC + 8, F.wave);
    const int lo = args.ph_lo, hi = args.ph_hi;
#define IN(k) (lo <= (k) && (k) < hi)
#define SEAM(k) do { if (IN(k) && hi > (k) + 1) { xcd_barrier(bar); if (DBG_DOUBLE_BAR) xcd_barrier(bar); } } while (0)
#define NREP(k) ((((DBG_REPEAT) >> (k)) & 1) + 1)

    if (IN(0)) { for (int rep = 0; rep < NREP(0); ++rep) { p0_prologue(F); if (rep + 1 < NREP(0)) { VM_WAIT(); __syncthreads(); } } SEAM(0); }
    if (IN(1)) {
        for (int rep = 0; rep < NREP(1); ++rep) {
        if constexpr (P1_FP8) {
            { pg8::Gemm g{F.XN, F.WinT, M, P1_NB, D}; pg8::StaticOrder S; S.init(M, P1_NB, F.G, (int)blockIdx.x);
              pg8::EpiProj E{F.PROJ, F.QH, F.KH, F.VH, F.GH, F.GTA, F.GTB, 0};
              pg8::gemm_phase<pg8::EpiProj, pg8::StaticOrder, PG8_ALIGN, PG8_SP2>(F.lds + RING_OFF, g, S, E, F.wave); }
            { pg8::Gemm g{(const bf16*)F.XN8, (const bf16*)F.WinT8, M, NIN - P1_NB, D}; pg8::StaticOrder S; S.init(M, NIN - P1_NB, F.G, (int)blockIdx.x);
              pg8::EpiProj E{F.PROJ, F.QH, F.KH, F.VH, F.GH, F.GTA, F.GTB, P1_NB / 256};
              pg8::gemm_phase<pg8::EpiProj, pg8::StaticOrder, PG8_ALIGN, PG8_SP2, true, P1_SA, P1_SB>(F.lds + RING_OFF, g, S, E, F.wave); }
        } else {
        pg8::Gemm g{F.XN, F.WinT, M, NIN, D}; pg8::StaticOrder S; S.init(M, NIN, F.G, (int)blockIdx.x);
        pg8::EpiProj E{F.PROJ, F.QH, F.KH, F.VH, F.GH, F.GTA, F.GTB, 0};
        pg8::gemm_phase<pg8::EpiProj, pg8::StaticOrder, PG8_ALIGN, PG8_SP2>(F.lds + RING_OFF, g, S, E, F.wave); }
        VM_WAIT(); __syncthreads(); }
        SEAM(1);
    }
    if (IN(2)) { F.lane = mk_lane(); F.tid = F.wave * 64 + F.lane;
        constexpr int NS = BATCH * NCH * RH, NC = M / CV_TOK;
        for (int rep = 0; rep < NREP(2); ++rep) {
        { P2Regs R; int it = F.vcu; if (it < NS) p2_state_load(F, it, R);
          for (; it < NS; it += F.G) { p2_state_stage(F, it, R); __syncthreads(); if (it + F.G < NS) p2_state_load(F, it + F.G, R); p2_state_compute(F, it); __syncthreads(); } }
        for (int rep2 = 0; rep2 < 1 + DBG_CONVREP; ++rep2)
        for (int it = F.vcu; it < NC; it += F.G) p2_conv_item(F, it);
        }
        SEAM(2);
    }
    if (IN(3)) { F.lane = mk_lane(); F.tid = F.wave * 64 + F.lane;
        p3_scan(F);
        SEAM(3); }
    if (IN(4)) { F.lane = mk_lane(); F.tid = F.wave * 64 + F.lane;
        for (int rep = 0; rep < NREP(4); ++rep) {
          constexpr int NI = BATCH * NCH * RH;
          P4Regs R; int it = F.vcu; if (it < NI) p4_load(F, it, R);
          for (; it < NI; it += F.G) {
              p4_stage(F, it, R); v4u gcur[4];
#pragma unroll
              for (int i = 0; i < 4; ++i) gcur[i] = R.g[i];
              __syncthreads();
              if (it + F.G < NI) p4_load(F, it + F.G, R);
              p4_compute(F, it, gcur);
          }
        }
        SEAM(4);
    }
    if (IN(5)) { F.lane = mk_lane(); F.tid = F.wave * 64 + F.lane;
#if DBG_PROBE
        dbg_probe(F, 1);
#endif
        for (int rep = 0; rep < NREP(5); ++rep) {
          pg8::Gemm g{F.CB, F.WcT, M, D, CCH, F.RA, F.WrT}; pg8::DualOrder S; S.init(M, D, F.G, (int)blockIdx.x);
          pg8::EpiGateChain E{F.XN, D, F.GTA, F.GTB, F.b_conv_proj};
          pg8::gemm_phase<pg8::EpiGateChain, pg8::DualOrder, PG8_ALIGN, PG8_SP2>(F.lds + RING_OFF, g, S, E, F.wave); VM_WAIT(); __syncthreads(); }
        SEAM(5);
    }
    if (IN(6)) { F.lane = mk_lane(); F.tid = F.wave * 64 + F.lane;
        for (int rep = 0; rep < NREP(6); ++rep) {
        pg8::Gemm g{F.XN, F.WoT, M, D, D}; pg8::StaticOrder S; S.init(M, D, F.G, (int)blockIdx.x);
        pg8::EpiResBf16SS E{F.X1, D, F.x, F.SS};
        pg8::gemm_phase<pg8::EpiResBf16SS, pg8::StaticOrder, PG8_ALIGN, PG8_SP2, P6_FP8, P6_SA, P6_SB>(F.lds + RING_OFF, g, S, E, F.wave);
        VM_WAIT(); __syncthreads(); }
        SEAM(6);
    }
    if (IN(8)) { F.lane = mk_lane(); F.tid = F.wave * 64 + F.lane;
        for (int rep = 0; rep < NREP(8); ++rep) {
        pg8::Gemm g{F.X1, F.WqT, M, NSC, D}; pg8::StaticOrder S; S.init(M, NSC, F.G, (int)blockIdx.x);
        pg8::EpiF16Rstd E{F.SC, NSC, F.SS, 1.0f / D, RMS_EPS};
        pg8::gemm_phase<pg8::EpiF16Rstd, pg8::StaticOrder, PG8_ALIGN, PG8_SP2>(F.lds + RING_OFF, g, S, E, F.wave);
        VM_WAIT(); __syncthreads(); }
        SEAM(8);
    }
    if (IN(9)) { F.lane = mk_lane(); F.tid = F.wave * 64 + F.lane;
#if DBG_DUMMY_EMASK
        p9_phase(F, DBG_DUMMY_EMASK, true);
#endif
        for (int rep = 0; rep < NREP(9); ++rep) p9_phase(F);
    }
#undef IN
#undef SEAM
}

extern "C" void kernel_launch(void* const* d_in, const int* in_sizes, int n_in, void* d_out, int out_size, void* d_ws, size_t ws_size, hipStream_t stream) {
    static int grid = 0;
    if (grid == 0) {
        if (n_in != 18 || in_sizes[0] != M * D || out_size != M * D || ws_size < WS_END) { fprintf(stderr, "kernel_launch: unexpected problem shape (n_in %d, in0 %d, out %d, ws %zu); nothing launched\n", n_in, n_in > 0 ? in_sizes[0] : -1, out_size, ws_size); grid = -1; return; }
        int dev = 0, cus = 0, per_cu = 0;
        if (hipGetDevice(&dev) != hipSuccess || hipDeviceGetAttribute(&cus, hipDeviceAttributeMultiprocessorCount, dev) != hipSuccess) { fprintf(stderr, "kernel_launch: device query failed\n"); grid = -1; return; }
        if (hipFuncSetAttribute((const void*)mk_fwd, hipFuncAttributeMaxDynamicSharedMemorySize, LDS_BYTES) != hipSuccess) { fprintf(stderr, "kernel_launch: hipFuncSetAttribute failed\n"); grid = -1; return; }
        if (hipOccupancyMaxActiveBlocksPerMultiprocessor(&per_cu, (const void*)mk_fwd, NWAVES * 64, LDS_BYTES) != hipSuccess || per_cu < 1) { fprintf(stderr, "kernel_launch: occupancy query reports %d workgroups per CU\n", per_cu); (void)hipGetLastError(); grid = -1; return; }
        grid = cus;
    }
    if (grid < 0) return;
    (void)hipMemsetAsync((char*)d_ws + WS_CTL, 0, CTL_ZERO_BYTES, stream);
    Args a{};
    for (int i = 0; i < 18; ++i) a.in[i] = (const float*)d_in[i];
    a.out = (float*)d_out; a.ws = (unsigned char*)d_ws;
#if MK_PER_PHASE
    for (int p = 0; p < N_PHASES; ++p) { if (!((DBG_PHASE_MASK >> p) & 1)) continue; a.ph_lo = p; a.ph_hi = p + 1; hipLaunchKernelGGL(mk_fwd, dim3(grid), dim3(NWAVES * 64), LDS_BYTES, stream, a); }
#else
    a.ph_lo = 0; a.ph_hi = N_PHASES;
    hipLaunchKernelGGL(mk_fwd, dim3(grid), dim3(NWAVES * 64), LDS_BYTES, stream, a);
#endif
    const hipError_t le = hipPeekAtLastError();
    if (le != hipSuccess) fprintf(stderr, "kernel_launch: launch failed: %s\n", hipGetErrorName(le));
}
```

```cpp
#include <hip/hip_runtime.h>
#include <cstdio>
#include <cstdint>
#ifndef P1_FP8
#define P1_FP8 true
#endif
constexpr int P1_SA = 3, P1_SB = 6, P1_NB = 2048;
#ifndef GATE_FP8
#define GATE_FP8 true
#endif
#ifndef P6_FP8
#define P6_FP8 false
#endif
constexpr int P6_SA = 2, P6_SB = 6;
__device__ __forceinline__ int mk_lane() { int l; asm volatile("v_mbcnt_lo_u32_b32 %0, -1, 0\n\tv_mbcnt_hi_u32_b32 %0, -1, %0" : "=v"(l)); return l; }
namespace pg8 {
#define PG8_LAS __attribute__((address_space(3)))
typedef unsigned short bf16_t;
typedef short bf16x8 __attribute__((ext_vector_type(8)));
typedef int v4i_t __attribute__((ext_vector_type(4)));
typedef int v8i_t __attribute__((ext_vector_type(8)));
typedef float f32x4 __attribute__((ext_vector_type(4)));
typedef unsigned u32x4 __attribute__((ext_vector_type(4)));
typedef unsigned u32x2 __attribute__((ext_vector_type(2)));
constexpr int BM = 256, BK = 64, HALF = 128, HTB = HALF * BK * 2  , STAGE_BYTES = 8 * HTB, NXCD = 8, WGM = 8;

__host__ __device__ __forceinline__ int lds_byte(int r, int c) { const int st = (r >> 4) * 2 + (c >> 5), rr = r & 15, cc = c & 31, ob = rr * 64 + cc * 2; return st * 1024 + (ob ^ (((ob >> 9) & 1) << 5)); }
__host__ __device__ __forceinline__ void stage_rc(int b, int& R, int& C) { const int st = b / 1024, sb = b % 1024, swz = sb ^ (((sb >> 9) & 1) << 5); R = (st >> 1) * 16 + swz / 64; C = (st & 1) * 32 + (swz % 64) / 2; }
__host__ __device__ __forceinline__ int perm32(int rho) { const int n = rho >> 4, i = rho & 15; return 8 * (i >> 2) + 4 * n + (i & 3); }

struct Unit { int pm, pn, br; };
struct Gemm { const bf16_t* A; const bf16_t* Bt; int M, N, K; const bf16_t* A2; const bf16_t* Bt2; };

struct StaticOrder {
    int nM, nN, nwg, G, c;
    __host__ __device__ void init(int M, int N, int G_, int c_) { nM = M / BM; nN = N / BM; nwg = nM * nN; G = G_; c = c_; }
    __host__ __device__ bool next(int i, Unit& u) const {
        const long L = (long)i * G + c; if (L >= nwg) return false;
        int wgid = (int)L; { const int q = nwg / NXCD, r = nwg % NXCD, xcd = wgid % NXCD, off = wgid / NXCD; wgid = (xcd < r ? xcd * (q + 1) : r * (q + 1) + (xcd - r) * q) + off; }
        const int nig = WGM * nN, gid = wgid / nig, fm = gid * WGM, gsz = (nM - fm) < WGM ? (nM - fm) : WGM;
        u.pm = fm + ((wgid % nig) % gsz); u.pn = (wgid % nig) / gsz; u.br = 0; return true;
    }
    __device__ __forceinline__ void a_ready(const Unit&) const {}
    __device__ __forceinline__ void done(const Unit&) const {}
};
struct DualOrder : StaticOrder {
    __host__ __device__ bool next(int i, Unit& u) const { if (!StaticOrder::next(i >> 1, u)) return false; u.br = i & 1; return true; }
};

__device__ __forceinline__ unsigned cvt_pk_bf16(float lo, float hi) { typedef __bf16 bf16x2_t __attribute__((ext_vector_type(2))); bf16x2_t r; r.x = (__bf16)lo; r.y = (__bf16)hi; return __builtin_bit_cast(unsigned, r); }

__device__ __forceinline__ float bf_lo(unsigned w) { return __builtin_bit_cast(float, w << 16); }
__device__ __forceinline__ float bf_hi(unsigned w) { return __builtin_bit_cast(float, w & 0xffff0000u); }
__device__ __forceinline__ float sigmoidf_fast(float x) { return __builtin_amdgcn_rcpf(1.0f + __builtin_amdgcn_exp2f(-1.4426950408889634f * x)); }

struct EpiBf16Plain {
    static constexpr bool PERM = true, AFTER_DRAIN = false, CHAIN = false;
    bf16_t* O; int ldc;
    __device__ __forceinline__ void operator()(const f32x4 (&acc)[2][2][4][2], const Unit& u, int wr, int wc, int fr, int fq) const {
        const int row0 = u.pm * BM + wr * 64 + fr, col0 = u.pn * BM + wc * 32 + 8 * fq;
#pragma unroll
        for (int ai = 0; ai < 2; ++ai)
#pragma unroll
            for (int m = 0; m < 4; ++m) { bf16_t* rowp = O + (size_t)(row0 + ai * HALF + m * 16) * ldc + col0;
#pragma unroll
                for (int bj = 0; bj < 2; ++bj) { const f32x4 v0 = acc[ai][bj][m][0], v1 = acc[ai][bj][m][1];
                    u32x4 w; w.x = cvt_pk_bf16(v0[0], v0[1]); w.y = cvt_pk_bf16(v0[2], v0[3]); w.z = cvt_pk_bf16(v1[0], v1[1]); w.w = cvt_pk_bf16(v1[2], v1[3]);
                    *(u32x4*)(rowp + bj * HALF) = w; } }
    }
};
struct EpiF16Plain {
    static constexpr bool PERM = true, AFTER_DRAIN = false, CHAIN = false;
    unsigned short* O; int ldc;
    __device__ __forceinline__ static unsigned pkh(float a, float b) { typedef _Float16 h2 __attribute__((ext_vector_type(2))); h2 h; h.x = (_Float16)a; h.y = (_Float16)b; return __builtin_bit_cast(unsigned, h); }
    __device__ __forceinline__ void operator()(const f32x4 (&acc)[2][2][4][2], const Unit& u, int wr, int wc, int fr, int fq) const {
        const int row0 = u.pm * BM + wr * 64 + fr, col0 = u.pn * BM + wc * 32 + 8 * fq;
#pragma unroll
        for (int ai = 0; ai < 2; ++ai)
#pragma unroll
            for (int m = 0; m < 4; ++m) { unsigned short* rowp = O + (size_t)(row0 + ai * HALF + m * 16) * ldc + col0;
#pragma unroll
                for (int bj = 0; bj < 2; ++bj) { const f32x4 v0 = acc[ai][bj][m][0], v1 = acc[ai][bj][m][1];
                    u32x4 w; w.x = pkh(v0[0], v0[1]); w.y = pkh(v0[2], v0[3]); w.z = pkh(v1[0], v1[1]); w.w = pkh(v1[2], v1[3]);
                    *(u32x4*)(rowp + bj * HALF) = w; } }
    }
};
struct EpiGateA {
    static constexpr bool PERM = true, AFTER_DRAIN = false, CHAIN = false;
    bf16_t* T; int ldc; const bf16_t* G; int ldg;
    __device__ __forceinline__ void operator()(const f32x4 (&acc)[2][2][4][2], const Unit& u, int wr, int wc, int fr, int fq) const {
        const int row0 = u.pm * BM + wr * 64 + fr, col0 = u.pn * BM + wc * 32 + 8 * fq;
#pragma unroll
        for (int ai = 0; ai < 2; ++ai)
#pragma unroll
            for (int m = 0; m < 4; ++m) { const int row = row0 + ai * HALF + m * 16; bf16_t* rowp = T + (size_t)row * ldc + col0; const bf16_t* gp = G + (size_t)row * ldg + col0;
#pragma unroll
                for (int bj = 0; bj < 2; ++bj) { const f32x4 v0 = acc[ai][bj][m][0], v1 = acc[ai][bj][m][1];
                    const u32x4 g = *(const u32x4*)(gp + bj * HALF);
                    u32x4 w;
                    w.x = cvt_pk_bf16(v0[0] * sigmoidf_fast(bf_lo(g.x)), v0[1] * sigmoidf_fast(bf_hi(g.x)));
                    w.y = cvt_pk_bf16(v0[2] * sigmoidf_fast(bf_lo(g.y)), v0[3] * sigmoidf_fast(bf_hi(g.y)));
                    w.z = cvt_pk_bf16(v1[0] * sigmoidf_fast(bf_lo(g.z)), v1[1] * sigmoidf_fast(bf_hi(g.z)));
                    w.w = cvt_pk_bf16(v1[2] * sigmoidf_fast(bf_lo(g.w)), v1[3] * sigmoidf_fast(bf_hi(g.w)));
                    *(u32x4*)(rowp + bj * HALF) = w; } }
    }
};
struct EpiGateB {
    static constexpr bool PERM = true, AFTER_DRAIN = false, CHAIN = false;
    bf16_t* T; int ldc; const bf16_t* G; int ldg; const float* bias;
    __device__ __forceinline__ void operator()(const f32x4 (&acc)[2][2][4][2], const Unit& u, int wr, int wc, int fr, int fq) const {
        const int row0 = u.pm * BM + wr * 64 + fr, col0 = u.pn * BM + wc * 32 + 8 * fq;
        f32x4 bv[2][2];
#pragma unroll
        for (int bj = 0; bj < 2; ++bj)
#pragma unroll
            for (int n = 0; n < 2; ++n) bv[bj][n] = *(const f32x4*)(bias + col0 + bj * HALF + 4 * n);
#pragma unroll
        for (int ai = 0; ai < 2; ++ai)
#pragma unroll
            for (int m = 0; m < 4; ++m) { const int row = row0 + ai * HALF + m * 16; bf16_t* rowp = T + (size_t)row * ldc + col0; const bf16_t* gp = G + (size_t)row * ldg + col0;
#pragma unroll
                for (int bj = 0; bj < 2; ++bj) { const f32x4 v0 = acc[ai][bj][m][0] + bv[bj][0], v1 = acc[ai][bj][m][1] + bv[bj][1];
                    const u32x4 g = *(const u32x4*)(gp + bj * HALF);
                    const u32x4 t = *(const u32x4*)(rowp + bj * HALF);
                    u32x4 w;
                    w.x = cvt_pk_bf16(bf_lo(t.x) + v0[0] * sigmoidf_fast(bf_lo(g.x)), bf_hi(t.x) + v0[1] * sigmoidf_fast(bf_hi(g.x)));
                    w.y = cvt_pk_bf16(bf_lo(t.y) + v0[2] * sigmoidf_fast(bf_lo(g.y)), bf_hi(t.y) + v0[3] * sigmoidf_fast(bf_hi(g.y)));
                    w.z = cvt_pk_bf16(bf_lo(t.z) + v1[0] * sigmoidf_fast(bf_lo(g.z)), bf_hi(t.z) + v1[1] * sigmoidf_fast(bf_hi(g.z)));
                    w.w = cvt_pk_bf16(bf_lo(t.w) + v1[2] * sigmoidf_fast(bf_lo(g.w)), bf_hi(t.w) + v1[3] * sigmoidf_fast(bf_hi(g.w)));
                    *(u32x4*)(rowp + bj * HALF) = w; } }
    }
};
struct EpiResF32 {
    static constexpr bool PERM = false, AFTER_DRAIN = false, CHAIN = false;
    float* C; int ldc; const float* R;
    __device__ __forceinline__ void operator()(const f32x4 (&acc)[2][2][4][2], const Unit& u, int wr, int wc, int fr, int fq) const {
        const int row0 = u.pm * BM + wr * 64 + fr, col0 = u.pn * BM + wc * 32 + 4 * fq;
#pragma unroll
        for (int ai = 0; ai < 2; ++ai)
#pragma unroll
            for (int m = 0; m < 4; ++m) { const size_t off = (size_t)(row0 + ai * HALF + m * 16) * ldc + col0;
#pragma unroll
                for (int bj = 0; bj < 2; ++bj)
#pragma unroll
                    for (int n = 0; n < 2; ++n) *(f32x4*)(C + off + bj * HALF + n * 16) = acc[ai][bj][m][n] + *(const f32x4*)(R + off + bj * HALF + n * 16); }
    }
};
struct EpiResBf16SS {
    static constexpr bool PERM = true, AFTER_DRAIN = false, CHAIN = false;
    bf16_t* O; int ldc; const float* R; float* SS;
    __device__ __forceinline__ void operator()(const f32x4 (&acc)[2][2][4][2], const Unit& u, int wr, int wc, int fr, int fq) const {
        int upm = u.pm, upn = u.pn; asm volatile("" : "+s"(upm), "+s"(upn)); const int lnow = mk_lane(), frv = lnow & 15, fqv = lnow >> 4;
        const int row0 = upm * BM + wr * 64 + frv, col0 = upn * BM + wc * 32 + 8 * fqv;
#pragma unroll
        for (int ai = 0; ai < 2; ++ai)
#pragma unroll
            for (int m = 0; m < 4; ++m) { const int row = row0 + ai * HALF + m * 16; const size_t off = (size_t)row * ldc + col0; float ssq = 0.f;
#pragma unroll
                for (int bj = 0; bj < 2; ++bj) { const f32x4 v0 = acc[ai][bj][m][0] + *(const f32x4*)(R + off + bj * HALF), v1 = acc[ai][bj][m][1] + *(const f32x4*)(R + off + bj * HALF + 4);
                    ssq += (v0[0] * v0[0] + v0[1] * v0[1]) + (v0[2] * v0[2] + v0[3] * v0[3]) + (v1[0] * v1[0] + v1[1] * v1[1]) + (v1[2] * v1[2] + v1[3] * v1[3]);
                    u32x4 w; w.x = cvt_pk_bf16(v0[0], v0[1]); w.y = cvt_pk_bf16(v0[2], v0[3]); w.z = cvt_pk_bf16(v1[0], v1[1]); w.w = cvt_pk_bf16(v1[2], v1[3]);
                    *(u32x4*)(O + off + bj * HALF) = w; }
                ssq += __shfl_xor(ssq, 16); ssq += __shfl_xor(ssq, 32);
                if (fqv == 0) SS[(size_t)row * 16 + upn * 4 + wc] = ssq; }
    }
};
struct EpiF16Rstd {
    static constexpr bool PERM = true, AFTER_DRAIN = false, CHAIN = false;
    unsigned short* O; int ldc; const float* SS; float inv_nd, eps;
    __device__ __forceinline__ void operator()(const f32x4 (&acc)[2][2][4][2], const Unit& u, int wr, int wc, int fr, int fq) const {
        const int row0 = u.pm * BM + wr * 64 + fr, col0 = u.pn * BM + wc * 32 + 8 * fq;
#pragma unroll
        for (int ai = 0; ai < 2; ++ai)
#pragma unroll
            for (int m = 0; m < 4; ++m) { const int row = row0 + ai * HALF + m * 16; unsigned short* rowp = O + (size_t)row * ldc + col0;
                const f32x4* sp = (const f32x4*)(SS + (size_t)row * 16); const f32x4 s0 = sp[0], s1 = sp[1], s2 = sp[2], s3 = sp[3];
                const float tot = ((s0[0] + s0[1]) + (s0[2] + s0[3])) + ((s1[0] + s1[1]) + (s1[2] + s1[3])) + ((s2[0] + s2[1]) + (s2[2] + s2[3])) + ((s3[0] + s3[1]) + (s3[2] + s3[3]));
                const float rstd = 1.0f / __builtin_sqrtf(tot * inv_nd + eps);
#pragma unroll
                for (int bj = 0; bj < 2; ++bj) { const f32x4 v0 = acc[ai][bj][m][0] * rstd, v1 = acc[ai][bj][m][1] * rstd;
                    u32x4 w; w.x = EpiF16Plain::pkh(v0[0], v0[1]); w.y = EpiF16Plain::pkh(v0[2], v0[3]); w.z = EpiF16Plain::pkh(v1[0], v1[1]); w.w = EpiF16Plain::pkh(v1[2], v1[3]);
                    *(u32x4*)(rowp + bj * HALF) = w; } }
    }
};
struct EpiGateChain {
    static constexpr bool PERM = true, AFTER_DRAIN = false, CHAIN = true;
    bf16_t* T; int ldc; const bf16_t* GA; const bf16_t* GB; const float* bias;
    __device__ __forceinline__ static void gate8(const bf16_t* G, size_t off, float (&g)[8]) {
        if constexpr (GATE_FP8) { const u32x2 w = *(const u32x2*)((const unsigned char*)G + off);
            typedef float f2 __attribute__((ext_vector_type(2)));
            const f2 a = __builtin_amdgcn_cvt_pk_f32_fp8((int)w.x, false), b = __builtin_amdgcn_cvt_pk_f32_fp8((int)w.x, true), c = __builtin_amdgcn_cvt_pk_f32_fp8((int)w.y, false), d = __builtin_amdgcn_cvt_pk_f32_fp8((int)w.y, true);
            g[0] = a.x; g[1] = a.y; g[2] = b.x; g[3] = b.y; g[4] = c.x; g[5] = c.y; g[6] = d.x; g[7] = d.y; }
        else { const u32x4 w = *(const u32x4*)(G + off); g[0] = bf_lo(w.x); g[1] = bf_hi(w.x); g[2] = bf_lo(w.y); g[3] = bf_hi(w.y); g[4] = bf_lo(w.z); g[5] = bf_hi(w.z); g[6] = bf_lo(w.w); g[7] = bf_hi(w.w); }
    }
    __device__ __forceinline__ static float e_neg(float x) { return __builtin_amdgcn_exp2f(-1.4426950408889634f * fmaxf(x, -60.0f)); }
    __device__ __forceinline__ void mid(f32x4 (&acc)[2][2][4][2], const Unit& u, int wr, int wc, int fr, int fq) const {
        const int col0 = u.pn * BM + wc * 32 + 8 * fq;
        const size_t g0 = (size_t)(u.pm * 4 + u.pn) * 65536 + (size_t)(((wr * 4 + wc) * 64 + fq * 16 + fr) * 8);
        f32x4 bv[2][2];
#pragma unroll
        for (int bj = 0; bj < 2; ++bj)
#pragma unroll
            for (int n = 0; n < 2; ++n) bv[bj][n] = *(const f32x4*)(bias + col0 + bj * HALF + 4 * n);
#pragma unroll
        for (int ai = 0; ai < 2; ++ai)
#pragma unroll
            for (int m = 0; m < 4; ++m) {
#pragma unroll
                for (int bj = 0; bj < 2; ++bj) { const size_t goff = g0 + (size_t)(((ai * 4 + m) * 2 + bj) * 4096);
                    float ga8[8], gb8[8]; gate8(GA, goff, ga8); gate8(GB, goff, gb8);
#pragma unroll
                    for (int j = 0; j < 4; ++j) { const int n = j >> 1, c = 2 * (j & 1);
                        const float r0 = (1.0f + e_neg(ga8[2 * j])) * __builtin_amdgcn_rcpf(1.0f + e_neg(gb8[2 * j])), r1 = (1.0f + e_neg(ga8[2 * j + 1])) * __builtin_amdgcn_rcpf(1.0f + e_neg(gb8[2 * j + 1]));
                        acc[ai][bj][m][n][c] = (acc[ai][bj][m][n][c] + bv[bj][n][c]) * r0; acc[ai][bj][m][n][c + 1] = (acc[ai][bj][m][n][c + 1] + bv[bj][n][c + 1]) * r1; } } }
    }
    __device__ __forceinline__ void operator()(const f32x4 (&acc)[2][2][4][2], const Unit& u, int wr, int wc, int fr, int fq) const {
        const int row0 = u.pm * BM + wr * 64 + fr, col0 = u.pn * BM + wc * 32 + 8 * fq;
        const size_t g0 = (size_t)(u.pm * 4 + u.pn) * 65536 + (size_t)(((wr * 4 + wc) * 64 + fq * 16 + fr) * 8);
#pragma unroll
        for (int ai = 0; ai < 2; ++ai)
#pragma unroll
            for (int m = 0; m < 4; ++m) { const int row = row0 + ai * HALF + m * 16; bf16_t* rowp = T + (size_t)row * ldc + col0;
#pragma unroll
                for (int bj = 0; bj < 2; ++bj) { const f32x4 v0 = acc[ai][bj][m][0], v1 = acc[ai][bj][m][1];
                    float g8[8]; gate8(GA, g0 + (size_t)(((ai * 4 + m) * 2 + bj) * 4096), g8);
                    const float o0 = v0[0] * __builtin_amdgcn_rcpf(1.0f + e_neg(g8[0])), o1 = v0[1] * __builtin_amdgcn_rcpf(1.0f + e_neg(g8[1])), o2 = v0[2] * __builtin_amdgcn_rcpf(1.0f + e_neg(g8[2])), o3 = v0[3] * __builtin_amdgcn_rcpf(1.0f + e_neg(g8[3]));
                    const float o4 = v1[0] * __builtin_amdgcn_rcpf(1.0f + e_neg(g8[4])), o5 = v1[1] * __builtin_amdgcn_rcpf(1.0f + e_neg(g8[5])), o6 = v1[2] * __builtin_amdgcn_rcpf(1.0f + e_neg(g8[6])), o7 = v1[3] * __builtin_amdgcn_rcpf(1.0f + e_neg(g8[7]));
                    if constexpr (P6_FP8) { constexpr float sc = (float)(1 << P6_SA);
                        int p0 = __builtin_amdgcn_cvt_pk_fp8_f32(o0 * sc, o1 * sc, 0, false); p0 = __builtin_amdgcn_cvt_pk_fp8_f32(o2 * sc, o3 * sc, p0, true);
                        int p1 = __builtin_amdgcn_cvt_pk_fp8_f32(o4 * sc, o5 * sc, 0, false); p1 = __builtin_amdgcn_cvt_pk_fp8_f32(o6 * sc, o7 * sc, p1, true);
                        *(u32x2*)((unsigned char*)T + (size_t)row * ldc + col0 + bj * HALF) = (u32x2){(unsigned)p0, (unsigned)p1}; }
                    else { u32x4 w; w.x = cvt_pk_bf16(o0, o1); w.y = cvt_pk_bf16(o2, o3); w.z = cvt_pk_bf16(o4, o5); w.w = cvt_pk_bf16(o6, o7);
                        *(u32x4*)(rowp + bj * HALF) = w; } } }
    }
};
struct EpiProj {
    static constexpr bool PERM = true, AFTER_DRAIN = false, CHAIN = false;
    bf16_t *UVG, *QH, *KH, *VH, *GH, *GTA, *GTB; int pn0;
    template <long SA, long SM, long SB> __device__ __forceinline__ static void store_all(const f32x4 (&acc)[2][2][4][2], bf16_t* p) {
#pragma unroll
        for (int ai = 0; ai < 2; ++ai) {
#pragma unroll
            for (int m = 0; m < 4; ++m) {
#pragma unroll
                for (int bj = 0; bj < 2; ++bj) { const f32x4 v0 = acc[ai][bj][m][0], v1 = acc[ai][bj][m][1];
                    u32x4 w; w.x = cvt_pk_bf16(v0[0], v0[1]); w.y = cvt_pk_bf16(v0[2], v0[3]); w.z = cvt_pk_bf16(v1[0], v1[1]); w.w = cvt_pk_bf16(v1[2], v1[3]);
                    *(u32x4*)(p + bj * SB) = w; }
                p += SM; asm volatile("" : "+v"(p)); }
            p += SA - 4 * SM; }
    }
    __device__ __forceinline__ static void store_all8(unsigned char* p, const f32x4 (&acc)[2][2][4][2]) {
#pragma unroll
        for (int ai = 0; ai < 2; ++ai) {
#pragma unroll
            for (int m = 0; m < 4; ++m) {
#pragma unroll
                for (int bj = 0; bj < 2; ++bj) { const f32x4 v0 = acc[ai][bj][m][0], v1 = acc[ai][bj][m][1];
                    int p0 = __builtin_amdgcn_cvt_pk_fp8_f32(v0[0], v0[1], 0, false); p0 = __builtin_amdgcn_cvt_pk_fp8_f32(v0[2], v0[3], p0, true);
                    int p1 = __builtin_amdgcn_cvt_pk_fp8_f32(v1[0], v1[1], 0, false); p1 = __builtin_amdgcn_cvt_pk_fp8_f32(v1[2], v1[3], p1, true);
                    *(u32x2*)(p + bj * 4096) = (u32x2){(unsigned)p0, (unsigned)p1}; }
                p += 8192; asm volatile("" : "+v"(p)); }
            p += 32768 - 4 * 8192; }
    }
    __device__ __forceinline__ void operator()(const f32x4 (&acc)[2][2][4][2], const Unit& u, int wr, int wc, int fr, int fq) const {
        int upm = u.pm, upn = u.pn + pn0; asm volatile("" : "+s"(upm), "+s"(upn)); const int lnow = mk_lane(), frv = lnow & 15, fqv = lnow >> 4;
        const int cl0 = wc * 32 + 8 * fqv, tok0 = wr * 64 + frv;
        const int item0 = ((upm >> 4) * 32 + 2 * (upm & 15)) * 4;
        if (upn >= 10) { if constexpr (GATE_FP8) store_all8((unsigned char*)(upn < 14 ? GTA : GTB) + (size_t)(upm * 4 + ((upn - 10) & 3)) * 65536 + (int)(((wr * 4 + wc) * 64 + fqv * 16 + frv) * 8), acc);
                         else store_all<32768L, 8192L, 4096L>(acc, (upn < 14 ? GTA : GTB) + (size_t)(upm * 4 + ((upn - 10) & 3)) * 65536 + (int)(((wr * 4 + wc) * 64 + fqv * 16 + frv) * 8)); }
        else if (upn >= 6) store_all<(long)HALF * 1024, 16L * 1024, (long)HALF>(acc, UVG + ((size_t)(upm * BM) * 1024 + (upn - 6) * BM) + (int)(tok0 * 1024 + cl0));
        else if (upn < 2) store_all<4L * 128 * 64, 16L * 64, 2L * 128 * 64>(acc, (upn == 0 ? QH : KH) + (size_t)item0 * 8192 + (int)(((cl0 >> 6) * 128 + tok0) * 64 + (cl0 & 63)));
        else store_all<4L * 128 * 128, 16L * 128, 128L * 128>(acc, (upn < 4 ? VH : GH) + (size_t)(item0 + (upn & 1) * 2) * 16384 + (int)(tok0 * 128 + cl0));
    }
};


template <class Epi, class Sched, bool ALIGN_EPI = false, bool SP2 = false, bool FP8 = false, int FP8_SA = 0, int FP8_SB = 0>
__device__ __forceinline__ void gemm_phase(PG8_LAS unsigned char* lds, const Gemm g, const Sched& S, const Epi& E, const int wid  ) {
    const int lane = mk_lane(), tid = wid * 64 + lane, wr = wid >> 2, wc = wid & 3, fr = lane & 15, fq = lane >> 4;
    const int K = g.K, KB = FP8 ? K : 2 * K  , nt = KB / (BK * 2);
    unsigned voffA, voffB;
    { int R, C; stage_rc(tid * 16, R, C); const int Rb = Epi::PERM ? ((R & ~31) + perm32(R & 31)) : R;
        voffA = (unsigned)(R * KB + C * 2); voffB = (unsigned)(Rb * KB + C * 2); }
    const size_t kstep = (size_t)(BK * 2);
    const size_t hstep = (size_t)HALF * KB;
    const size_t tstep = 2 * hstep;
    const unsigned ldsw = (unsigned)wid * 1024u;
    const int aoff = lds_byte(wr * 64 + fr, fq * 8), boff = lds_byte(wc * 32 + fr, fq * 8);
#define PG8_SA(b, h) (((b) * 2 + (h)) * HTB)
#define PG8_SB(b, h) ((4 + (b) * 2 + (h)) * HTB)
#define PG8_STAGE(bufoff, gbase, voff) do { _Pragma("unroll") for (int _i = 0; _i < 2; ++_i) \
        __builtin_amdgcn_global_load_lds((const unsigned*)((const char*)(gbase) + (size_t)_i * 64 * KB + (voff)), (PG8_LAS unsigned*)(lds + (bufoff) + ldsw + _i * 8192), 16, 0, 0); } while (0)
#define PG8_LDA(dst, b, h) do { _Pragma("unroll") for (int m = 0; m < 4; ++m) _Pragma("unroll") for (int k = 0; k < 2; ++k) dst[m][k] = *(const PG8_LAS bf16x8*)(lds + PG8_SA(b, h) + aoff + m * 2048 + k * 1024); } while (0)
#define PG8_LDB(dst, b, h) do { _Pragma("unroll") for (int n = 0; n < 2; ++n) _Pragma("unroll") for (int k = 0; k < 2; ++k) dst[n][k] = *(const PG8_LAS bf16x8*)(lds + PG8_SB(b, h) + boff + n * 2048 + k * 1024); } while (0)
#define PG8_MMA(ai, bj, At, Bt) do { __builtin_amdgcn_s_setprio(1); _Pragma("unroll") for (int m = 0; m < 4; ++m) _Pragma("unroll") for (int n = 0; n < 2; ++n) { \
        if constexpr (FP8) { const v4i_t b0 = __builtin_bit_cast(v4i_t, Bt[n][0]), b1 = __builtin_bit_cast(v4i_t, Bt[n][1]), a0 = __builtin_bit_cast(v4i_t, At[m][0]), a1 = __builtin_bit_cast(v4i_t, At[m][1]); \
            acc[ai][bj][m][n] = __builtin_amdgcn_mfma_scale_f32_16x16x128_f8f6f4(__builtin_shufflevector(b0, b1, 0, 1, 2, 3, 4, 5, 6, 7), __builtin_shufflevector(a0, a1, 0, 1, 2, 3, 4, 5, 6, 7), acc[ai][bj][m][n], 0, 0, \
                0, 0, 0, 0); }   \
        else { _Pragma("unroll") for (int k = 0; k < 2; ++k) acc[ai][bj][m][n] = __builtin_amdgcn_mfma_f32_16x16x32_bf16(Bt[n][k], At[m][k], acc[ai][bj][m][n], 0, 0, 0); } } __builtin_amdgcn_s_setprio(0); } while (0)
#define PG8_WAIT_V(n) asm volatile("s_waitcnt vmcnt(" #n ")" ::: "memory")
#define PG8_WAIT_L(n) asm volatile("s_waitcnt lgkmcnt(" #n ")" ::: "memory")
#define PG8_BAR __builtin_amdgcn_s_barrier()
#define PG8_SCHED __builtin_amdgcn_sched_barrier(0)
    Unit cur, nxt; int ui = 0;
    if (!S.next(0, cur)) return;
    f32x4 acc[2][2][4][2];
#pragma unroll
    for (int a = 0; a < 2; ++a)
#pragma unroll
        for (int b = 0; b < 2; ++b)
#pragma unroll
            for (int m = 0; m < 4; ++m)
#pragma unroll
                for (int n = 0; n < 2; ++n) acc[a][b][m][n] = (f32x4){0.f, 0.f, 0.f, 0.f};
    bf16x8 At[4][2], B0[2][2], B1[2][2];
    const char* cA = (const char*)(cur.br ? g.A2 : g.A) + (size_t)cur.pm * tstep; const char* cB = (const char*)(cur.br ? g.Bt2 : g.Bt) + (size_t)cur.pn * tstep;
    S.a_ready(cur);
    if constexpr (SP2) {
        PG8_STAGE(PG8_SB(0, 0), cB, voffB); PG8_STAGE(PG8_SB(0, 1), cB + hstep, voffB); PG8_STAGE(PG8_SA(0, 0), cA, voffA); PG8_STAGE(PG8_SA(0, 1), cA + hstep, voffA);
        if (wr == 1) PG8_BAR;
        PG8_WAIT_V(2); PG8_BAR;
        PG8_STAGE(PG8_SB(1, 0), cB + kstep, voffB); PG8_STAGE(PG8_SA(1, 0), cA + kstep, voffA); PG8_STAGE(PG8_SB(1, 1), cB + hstep + kstep, voffB);
        PG8_WAIT_V(6); PG8_BAR;
    } else {
        PG8_STAGE(PG8_SB(0, 0), cB, voffB); PG8_STAGE(PG8_SA(0, 0), cA, voffA); PG8_STAGE(PG8_SB(0, 1), cB + hstep, voffB); PG8_STAGE(PG8_SA(0, 1), cA + hstep, voffA);
        if (wr == 1) PG8_BAR;
        PG8_WAIT_V(4); PG8_BAR;
        PG8_STAGE(PG8_SB(1, 0), cB + kstep, voffB); PG8_STAGE(PG8_SA(1, 0), cA + kstep, voffA); PG8_STAGE(PG8_SB(1, 1), cB + hstep + kstep, voffB);
        PG8_WAIT_V(6); PG8_BAR;
    }
    for (;;) {
        const bool has_next = S.next(ui + 1, nxt);
        const char* nA = has_next ? (const char*)(nxt.br ? g.A2 : g.A) + (size_t)nxt.pm * tstep : cA; const char* nB = has_next ? (const char*)(nxt.br ? g.Bt2 : g.Bt) + (size_t)nxt.pn * tstep : cB;
#pragma unroll 1
        for (int t = 0; t < nt; t += 2) {
            const bool last = (t == nt - 2);
            const char* a1 = cA + (size_t)(t + 1) * kstep;
            const char* a2 = last ? nA : cA + (size_t)(t + 2) * kstep; const char* b2 = last ? nB : cB + (size_t)(t + 2) * kstep;
            const char* a3 = a2 + kstep; const char* b3 = b2 + kstep;
            if (last && has_next) S.a_ready(nxt);
            if constexpr (SP2) {
            PG8_LDB(B0, 0, 0); PG8_LDB(B1, 0, 1); PG8_SCHED; PG8_LDA(At, 0, 0); PG8_STAGE(PG8_SA(1, 1), a1 + hstep, voffA);
            PG8_WAIT_V(8); PG8_WAIT_L(0); PG8_BAR; PG8_MMA(0, 0, At, B0); PG8_MMA(0, 1, At, B1); PG8_BAR; PG8_SCHED;
            PG8_LDA(At, 0, 1); PG8_STAGE(PG8_SB(0, 0), b2, voffB); PG8_STAGE(PG8_SB(0, 1), b2 + hstep, voffB); PG8_STAGE(PG8_SA(0, 0), a2, voffA);
            PG8_WAIT_V(8); PG8_WAIT_L(0); PG8_BAR; PG8_MMA(1, 0, At, B0); PG8_MMA(1, 1, At, B1); PG8_BAR; PG8_SCHED;
            PG8_LDB(B0, 1, 0); PG8_LDB(B1, 1, 1); PG8_SCHED; PG8_LDA(At, 1, 0); PG8_STAGE(PG8_SA(0, 1), a2 + hstep, voffA);
            PG8_WAIT_V(8); PG8_WAIT_L(0); PG8_BAR; PG8_MMA(0, 0, At, B0); PG8_MMA(0, 1, At, B1); PG8_BAR; PG8_SCHED;
            PG8_LDA(At, 1, 1); PG8_STAGE(PG8_SB(1, 0), b3, voffB); PG8_STAGE(PG8_SB(1, 1), b3 + hstep, voffB); PG8_STAGE(PG8_SA(1, 0), a3, voffA);
            PG8_WAIT_V(8); PG8_WAIT_L(0); PG8_BAR; PG8_MMA(1, 0, At, B0); PG8_MMA(1, 1, At, B1); PG8_BAR; PG8_SCHED;
            } else {
            PG8_LDB(B0, 0, 0); PG8_SCHED; PG8_LDA(At, 0, 0); PG8_STAGE(PG8_SA(1, 1), a1 + hstep, voffA);
            PG8_WAIT_L(8); PG8_BAR; PG8_WAIT_L(0); PG8_MMA(0, 0, At, B0); PG8_BAR; PG8_SCHED;
            PG8_LDB(B1, 0, 1); PG8_STAGE(PG8_SB(0, 0), b2, voffB);
            PG8_BAR; PG8_WAIT_L(0); PG8_MMA(0, 1, At, B1); PG8_BAR;
            PG8_LDA(At, 0, 1); PG8_STAGE(PG8_SA(0, 0), a2, voffA);
            PG8_BAR; PG8_WAIT_L(0); PG8_MMA(1, 0, At, B0); PG8_BAR; PG8_SCHED;
            PG8_STAGE(PG8_SB(0, 1), b2 + hstep, voffB);
            PG8_WAIT_V(6); PG8_BAR; PG8_MMA(1, 1, At, B1); PG8_BAR;
            PG8_LDB(B0, 1, 0); PG8_SCHED; PG8_LDA(At, 1, 0); PG8_STAGE(PG8_SA(0, 1), a2 + hstep, voffA);
            PG8_WAIT_L(8); PG8_BAR; PG8_WAIT_L(0); PG8_MMA(0, 0, At, B0); PG8_BAR; PG8_SCHED;
            PG8_LDB(B1, 1, 1); PG8_STAGE(PG8_SB(1, 0), b3, voffB);
            PG8_BAR; PG8_WAIT_L(0); PG8_MMA(0, 1, At, B1); PG8_BAR;
            PG8_LDA(At, 1, 1); PG8_STAGE(PG8_SA(1, 0), a3, voffA);
            PG8_BAR; PG8_WAIT_L(0); PG8_MMA(1, 0, At, B0); PG8_BAR; PG8_SCHED;
            PG8_STAGE(PG8_SB(1, 1), b3 + hstep, voffB);
            PG8_WAIT_V(6); PG8_BAR; PG8_MMA(1, 1, At, B1); PG8_BAR;
            }
        }
        if constexpr (ALIGN_EPI) { if (wr == 0) PG8_BAR; }
        if constexpr (FP8) {
#pragma unroll
            for (int a = 0; a < 2; ++a)
#pragma unroll
                for (int b = 0; b < 2; ++b)
#pragma unroll
                    for (int m = 0; m < 4; ++m)
#pragma unroll
                        for (int n = 0; n < 2; ++n) acc[a][b][m][n] *= 1.0f / (float)(1 << (FP8_SA + FP8_SB));
        }
        bool carry = false;
        if constexpr (Epi::CHAIN) { if (cur.br == 0) { E.mid(acc, cur, wr, wc, fr, fq); carry = true; } else E(acc, cur, wr, wc, fr, fq); }
        else if constexpr (!Epi::AFTER_DRAIN) { E(acc, cur, wr, wc, fr, fq); S.done(cur); }
        if (!has_next) break;
        if (!carry)
#pragma unroll
        for (int a = 0; a < 2; ++a)
#pragma unroll
            for (int b = 0; b < 2; ++b)
#pragma unroll
                for (int m = 0; m < 4; ++m)
#pragma unroll
                    for (int n = 0; n < 2; ++n) acc[a][b][m][n] = (f32x4){0.f, 0.f, 0.f, 0.f};
        cur = nxt; cA = nA; cB = nB; ++ui;
        if constexpr (ALIGN_EPI) { if (wr == 1) PG8_BAR; }
    }
    PG8_WAIT_V(0);
    if constexpr (!ALIGN_EPI) { if (wr == 0) PG8_BAR; }
    PG8_BAR;
    if constexpr (Epi::AFTER_DRAIN) { E.fused(acc, cur, wr, wc, fr, fq, lds, wid, lane); S.done(cur); }
#undef PG8_SA
#undef PG8_SB
#undef PG8_STAGE
#undef PG8_LDA
#undef PG8_LDB
#undef PG8_MMA
#undef PG8_WAIT_V
#undef PG8_WAIT_L
#undef PG8_BAR
#undef PG8_SCHED
}
}

constexpr int NWAVES = 8;
#ifndef MK_PER_PHASE
#define MK_PER_PHASE 0
#endif
constexpr int N_PHASES = 10;
#ifndef DBG_OUT
#define DBG_OUT 0
#endif
#ifndef DBG_SAN
#define DBG_SAN 0
#endif
#ifndef DBG_PROBE
#define DBG_PROBE 0
#endif
#define DBG_P1 (F.PROJ + t * NIN)
#define DBG_N1 (NIN / 8)
#define DBG_P2 (F.RA + t * RW)
#define DBG_N2 (RW / 8)
#define DBG_P3 (F.CB + t * CCH)
#define DBG_N3 (CCH / 8)
#ifndef DBG_ZFILL
#define DBG_ZFILL 0
#endif
#ifndef DBG_PHASE_MASK
#define DBG_PHASE_MASK 0x3ff
#endif
#ifndef DBG_REPEAT
#define DBG_REPEAT 0
#endif
#ifndef DBG_P0REP
#define DBG_P0REP 0
#endif
#ifndef DBG_DOUBLE_BAR
#define DBG_DOUBLE_BAR 0
#endif
#ifndef DBG_CONVREP
#define DBG_CONVREP 0
#endif
#ifndef DBG_DUMMY_EMASK
#define DBG_DUMMY_EMASK 0
#endif
#ifndef DBG_P9_VR
#define DBG_P9_VR 2
#endif
#ifndef DBG_ZF
#define DBG_ZF 1.0f
#endif
#ifndef DBG_TOPKREP
#define DBG_TOPKREP 0
#endif
#ifndef DBG_PRIO9
#define DBG_PRIO9 0
#endif
#ifndef DBG_SKIP_AXPY
#define DBG_SKIP_AXPY 0
#endif
#ifndef PG8_SP2
#define PG8_SP2 true
#endif
#ifndef PG8_ALIGN
#define PG8_ALIGN true
#endif

constexpr int BATCH = 8, SEQ = 4096, D = 1024, M = BATCH * SEQ;
constexpr int RH = 4, RDK = 64, RDV = 128, RW = 512, RC = 128, NCH = SEQ / RC;
constexpr int CCH = 512, CK = 31;
constexpr int NIN = 4608, NUVG = 1024;
constexpr int C_UV = 0, C_UG = 512;
constexpr int PH = 8, PQ = 256, PHALF = 128, NKEY = 128, NEXP = 16384, TOPK = 16, NSC = 2048;
constexpr float RMS_EPS = 1e-6f, LN_EPS = 1e-5f;

constexpr size_t MiB = 1u << 20;
constexpr size_t WS_CTL = 0, CTL_ZERO_BYTES = 64 * 1024;
constexpr size_t WS_ROPE = 1 * MiB;
constexpr size_t WS_WIN = 2 * MiB, WS_WR = 11 * MiB, WS_WC = 12 * MiB, WS_WO = 13 * MiB, WS_WQ = 15 * MiB;
constexpr size_t WS_UT = 20 * MiB, WS_VT = 28 * MiB, WS_USC = 52 * MiB, WS_VSC = 52 * MiB + 65536;
constexpr size_t WS_XN = 84 * MiB;
constexpr size_t WS_PROJ = 148 * MiB, WS_GTA = 212 * MiB, WS_GTB = 276 * MiB;
constexpr size_t WS_SC = WS_PROJ, WS_X1 = WS_PROJ + 128 * MiB, WS_SS = WS_PROJ + 192 * MiB;
constexpr size_t WS_XN8 = 342 * MiB, WS_WIN8 = 374 * MiB;
constexpr size_t WS_S = 436 * MiB;
constexpr size_t WS_QH = 452 * MiB, WS_KH = 468 * MiB;
constexpr size_t WS_END = 500 * MiB;
constexpr int CW_TMO = 0, CW_CODE = 1, CW_BAR = 4096;

constexpr int RING_OFF = 0, RING_BYTES = 131072;
constexpr int LDSCTL_OFF = RING_BYTES, MISC_OFF = LDSCTL_OFF + 320;
constexpr int LDS_BYTES = 147456;
static_assert(MISC_OFF + 128 <= LDS_BYTES, "LDS map");

#define GAS __attribute__((address_space(1)))
#define LAS __attribute__((address_space(3)))
typedef unsigned short bf16;
typedef unsigned v4u __attribute__((ext_vector_type(4)));
typedef unsigned v2u __attribute__((ext_vector_type(2)));
typedef float f32x4 __attribute__((ext_vector_type(4)));
typedef float f32x2 __attribute__((ext_vector_type(2)));
typedef short bf16x8 __attribute__((ext_vector_type(8)));
typedef __bf16 bf16x2v __attribute__((ext_vector_type(2)));
typedef GAS unsigned gu32;
#define RLX_AGENT __ATOMIC_RELAXED, __HIP_MEMORY_SCOPE_AGENT
#define LDS_WAIT() asm volatile("s_waitcnt lgkmcnt(0)" ::: "memory")
#define VM_WAIT() asm volatile("s_waitcnt vmcnt(0)" ::: "memory")
__device__ __forceinline__ unsigned f2bf(float f) { unsigned u = __builtin_bit_cast(unsigned, f); return (u + 0x7fffu + ((u >> 16) & 1u)) >> 16; }
__device__ __forceinline__ unsigned pk2(float lo, float hi) { return pg8::cvt_pk_bf16(lo, hi); }
__device__ __forceinline__ float bflo(unsigned w) { return __builtin_bit_cast(float, w << 16); }
__device__ __forceinline__ float bfhi(unsigned w) { return __builtin_bit_cast(float, w & 0xffff0000u); }
__device__ __forceinline__ float bf1(bf16 b) { return __builtin_bit_cast(float, (unsigned)b << 16); }
__device__ __forceinline__ float dot2bf(unsigned a, unsigned b, float acc) { return __builtin_amdgcn_fdot2_f32_bf16(__builtin_bit_cast(bf16x2v, a), __builtin_bit_cast(bf16x2v, b), acc, false); }
__device__ __forceinline__ float sigm(float x) { return __builtin_amdgcn_rcpf(1.0f + __builtin_amdgcn_exp2f(-1.4426950408889634f * x)); }
__device__ __forceinline__ float wave_sum(float v) {
#pragma unroll
    for (int o = 1; o < 64; o <<= 1) v += __shfl_xor(v, o);
    return v;
}

template <int CTRL, int RM = 0xf> __device__ __forceinline__ float dpp_get(float v) { return __builtin_bit_cast(float, __builtin_amdgcn_update_dpp(0, __builtin_bit_cast(int, v), CTRL, RM, 0xf, true)); }
__device__ __forceinline__ float quad_sum(float v) { v += dpp_get<0xB1>(v); v += dpp_get<0x4E>(v); return v; }
__device__ __forceinline__ float row16_sum(float v) { v = quad_sum(v); v += dpp_get<0x141>(v); v += dpp_get<0x140>(v); return v; }
__device__ __forceinline__ float wave_sum_dpp(float v) { v = row16_sum(v); v += dpp_get<0x142, 0xa>(v); v += dpp_get<0x143, 0xc>(v);
    return __builtin_bit_cast(float, __builtin_amdgcn_readlane(__builtin_bit_cast(int, v), 63)); }
__device__ __forceinline__ float wave_max_dpp(float v) {
    v = fmaxf(v, dpp_get<0xB1>(v)); v = fmaxf(v, dpp_get<0x4E>(v)); v = fmaxf(v, dpp_get<0x141>(v)); v = fmaxf(v, dpp_get<0x140>(v)); v = fmaxf(v, dpp_get<0x142, 0xa>(v)); v = fmaxf(v, dpp_get<0x143, 0xc>(v));
    return __builtin_bit_cast(float, __builtin_amdgcn_readlane(__builtin_bit_cast(int, v), 63)); }

#define XB_TMO      128
#define XB_XCNT(j)  (256  + 64 * (j))
#define XB_XSUB(j)  (1280 + 64 * (j))
#define XB_XGEN(j)  (2304 + 64 * (j))
#define XB_TOP      3328
#define XB_TOPGEN   3392
#define XCD_BAR_WORDS 3456
#define XB_SPIN_CAP (1u << 20)

__device__ __forceinline__ unsigned xb_ld(unsigned* p)              { return __hip_atomic_load(p, __ATOMIC_RELAXED, __HIP_MEMORY_SCOPE_AGENT); }
__device__ __forceinline__ unsigned xb_add(unsigned* p, unsigned v) { return __hip_atomic_fetch_add(p, v, __ATOMIC_RELAXED, __HIP_MEMORY_SCOPE_AGENT); }
__device__ __forceinline__ unsigned xb_xcc_id() { return (unsigned)__builtin_amdgcn_s_getreg((3 << 11) | 20) & 0xFu; }
#define XB_SPIN(cond, bar) do { unsigned _sp = 0; while (cond) { __builtin_amdgcn_s_sleep(1); \
    if ((++_sp & 255u) == 0u) { if (xb_ld(&(bar)[XB_TMO])) break; if (_sp > XB_SPIN_CAP) { atomicAdd(&(bar)[XB_TMO], 1u); break; } } } } while (0)

struct XcdBarrier { unsigned* bar; unsigned x; volatile LAS unsigned* st; int wave; };

__device__ __forceinline__ XcdBarrier xcd_barrier_post(unsigned* bar, volatile LAS unsigned* st, int wave) {
    XcdBarrier b; b.bar = bar; b.x = xb_xcc_id(); b.st = st; b.wave = wave;
    if (wave == 0 && mk_lane() == 0) (void)xb_add(&bar[XB_XCNT(b.x)], 1u);
    return b;
}
__device__ __forceinline__ void xcd_barrier_complete(unsigned* bar, unsigned x, unsigned& nloc, unsigned& nx) {
    const unsigned G = gridDim.x * gridDim.y * gridDim.z;
    unsigned sum, cnt, mine, sp = 0u;
    for (;;) {
        sum = 0u; cnt = 0u; mine = 0u;
#pragma unroll
        for (unsigned j = 0; j < 16; ++j) { const unsigned c = xb_ld(&bar[XB_XCNT(j)]); sum += c; cnt += (c > 0u) ? 1u : 0u; mine = (j == x) ? c : mine; }
        if (sum == G) break;
        __builtin_amdgcn_s_sleep(1);
        if ((++sp & 255u) == 0u) { if (xb_ld(&bar[XB_TMO])) break; if (sp > XB_SPIN_CAP) { atomicAdd(&bar[XB_TMO], 1u); break; } }
    }
    nloc = mine > 0u ? mine : 1u; nx = cnt > 0u ? cnt : 1u;
}
__device__ __forceinline__ void xcd_barrier(const XcdBarrier& b) {
    asm volatile("s_waitcnt vmcnt(0)" ::: "memory");
    __syncthreads();
    if (b.wave == 0 && mk_lane() == 0) {
        unsigned* bar = b.bar;
        __builtin_amdgcn_s_waitcnt(0);
        unsigned nloc = b.st[0], nx = b.st[1];
        if (nloc == 0u) { xcd_barrier_complete(bar, b.x, nloc, nx); b.st[0] = nloc; b.st[1] = nx; }
        const unsigned old = xb_add(&bar[XB_XSUB(b.x)], 1u);
        const unsigned gen = old / nloc;
        if (old + 1u == (gen + 1u) * nloc) {
            __builtin_amdgcn_fence(__ATOMIC_RELEASE, "agent");
            asm volatile("s_waitcnt vmcnt(0)" ::: "memory");
            const unsigned og = xb_add(&bar[XB_TOP], 1u);
            const unsigned tg = og / nx;
            if (og + 1u == (tg + 1u) * nx) xb_add(&bar[XB_TOPGEN], 1u);
            else XB_SPIN(xb_ld(&bar[XB_TOPGEN]) == tg, bar);
            __builtin_amdgcn_fence(__ATOMIC_ACQUIRE, "agent");
            xb_add(&bar[XB_XGEN(b.x)], 1u);
            asm volatile("s_waitcnt vmcnt(0)" ::: "memory");
        } else {
            XB_SPIN(xb_ld(&bar[XB_XGEN(b.x)]) == gen, bar);
            __builtin_amdgcn_fence(__ATOMIC_ACQUIRE, "agent");
            asm volatile("s_waitcnt vmcnt(0)" ::: "memory");
        }
    }
    __syncthreads();
}

struct Frame {
    LAS unsigned char* lds;
    volatile LAS unsigned* MISC;
    gu32* ctl;
    int tid, lane, wave;
    int vcu, G;
    const float *x, *rms_mix_g, *w_in, *ret_gn_g, *conv_dw_w, *conv_dw_b, *conv_ln_g, *conv_ln_b, *w_ret_proj, *w_conv_proj, *b_conv_proj, *w_out, *rms_ffn_g, *w_query, *sub_keys, *peer_u, *peer_v, *rms_final_g;
    float* out;
    f32x2* ROPE; bf16 *WinT, *WrT, *WcT, *WoT, *WqT, *XN, *PROJ, *S, *RA, *CB, *QH, *KH, *VH, *GH, *GTA, *GTB; unsigned char *UT, *VT, *XN8, *WinT8; float *USC, *VSC; unsigned short* SC; bf16* X1; float* SS;
};

template <bool FP8 = false, int SH = 0> __device__ __forceinline__ void p0_transpose_item(const float* W, int K, int N, bf16* WT, LAS float* scr, int item, int lane, int nsub = 0) {
    const int nblk = N / 32, kb = item / nblk, nb = item % nblk, k0 = 64 * kb, n0 = 32 * nb;
#pragma unroll 8
    for (int i = 0; i < 32; ++i) { const int kk = 2 * i + (lane >> 5); scr[kk * 33 + (lane & 31)] = W[(size_t)(k0 + kk) * N + n0 + (lane & 31)]; }
    LDS_WAIT(); asm volatile("" ::: "memory");
    const int c = lane & 7;
#pragma unroll
    for (int j = 0; j < 4; ++j) { const int n = (lane >> 3) + 8 * j; const LAS float* s = scr + (8 * c) * 33 + n;
        if constexpr (FP8) { constexpr float sc = (float)(1 << SH); v2u o;
            { int p = __builtin_amdgcn_cvt_pk_fp8_f32(s[0 * 33] * sc, s[1 * 33] * sc, 0, false); p = __builtin_amdgcn_cvt_pk_fp8_f32(s[2 * 33] * sc, s[3 * 33] * sc, p, true); o.x = (unsigned)p; }
            { int p = __builtin_amdgcn_cvt_pk_fp8_f32(s[4 * 33] * sc, s[5 * 33] * sc, 0, false); p = __builtin_amdgcn_cvt_pk_fp8_f32(s[6 * 33] * sc, s[7 * 33] * sc, p, true); o.y = (unsigned)p; }
            *(v2u*)((unsigned char*)WT + (size_t)(n0 + n - nsub) * K + k0 + 8 * c) = o; }
        else { v4u o; o.x = pk2(s[0 * 33], s[1 * 33]); o.y = pk2(s[2 * 33], s[3 * 33]); o.z = pk2(s[4 * 33], s[5 * 33]); o.w = pk2(s[6 * 33], s[7 * 33]);
            *(v4u*)(WT + (size_t)(n0 + n - nsub) * K + k0 + 8 * c) = o; } }
    LDS_WAIT(); asm volatile("" ::: "memory");
}
template <int R, bool FP8 = false, int SH = 0> __device__ __forceinline__ void rms_rows_to_bf16(int lane, const float* xrow, const float* g, bf16* orow, unsigned char* orow8 = nullptr) {
    const f32x4* gr = (const f32x4*)g + lane;
    f32x4 v[R][4]; float s[R];
#pragma unroll
    for (int r = 0; r < R; ++r) { const f32x4* xr = (const f32x4*)(xrow + (size_t)r * D) + lane;
#pragma unroll
        for (int j = 0; j < 4; ++j) v[r][j] = xr[64 * j]; }
#pragma unroll
    for (int r = 0; r < R; ++r) { float a = 0.f;
#pragma unroll
        for (int j = 0; j < 4; ++j) a += (v[r][j].x * v[r][j].x + v[r][j].y * v[r][j].y) + (v[r][j].z * v[r][j].z + v[r][j].w * v[r][j].w);
        s[r] = a; }
#pragma unroll
    for (int o = 1; o < 64; o <<= 1) {
#pragma unroll
        for (int r = 0; r < R; ++r) s[r] += __shfl_xor(s[r], o); }
    f32x4 gg[4];
#pragma unroll
    for (int j = 0; j < 4; ++j) gg[j] = gr[64 * j];
#pragma unroll
    for (int r = 0; r < R; ++r) { const float rstd = 1.f / sqrtf(s[r] * (1.f / D) + RMS_EPS);
        if constexpr (FP8) { unsigned* o4 = (unsigned*)(orow8 + (size_t)r * D) + lane; constexpr float sc = (float)(1 << SH);
#pragma unroll
            for (int j = 0; j < 4; ++j) { int p = __builtin_amdgcn_cvt_pk_fp8_f32(v[r][j].x * rstd * gg[j].x * sc, v[r][j].y * rstd * gg[j].y * sc, 0, false); p = __builtin_amdgcn_cvt_pk_fp8_f32(v[r][j].z * rstd * gg[j].z * sc, v[r][j].w * rstd * gg[j].w * sc, p, true); o4[64 * j] = (unsigned)p; } }
        { v2u* o8 = (v2u*)(orow + (size_t)r * D) + lane;
#pragma unroll
            for (int j = 0; j < 4; ++j) { v2u o; o.x = pk2(v[r][j].x * rstd * gg[j].x, v[r][j].y * rstd * gg[j].y); o.y = pk2(v[r][j].z * rstd * gg[j].z, v[r][j].w * rstd * gg[j].w); o8[64 * j] = o; } } }
}
__device__ __forceinline__ void p0_fold_task(Frame& F, int task) {
    const int nq = task & 7, kg = (task >> 3) & 15, hp = task >> 7;
    const int k = kg * 64 + F.lane;
    const f32x4* wq = (const f32x4*)(F.w_query + (size_t)k * (PH * PQ) + hp * 128);
    f32x4 w[32];
#pragma unroll
    for (int i = 0; i < 32; ++i) w[i] = wq[i];
    const float gk = F.rms_ffn_g[k];
    for (int n = nq * 16; n < nq * 16 + 16; ++n) {
        const f32x4* sk = (const f32x4*)(F.sub_keys + ((size_t)hp * 128 + n) * 128);
        float a0 = 0.f, a1 = 0.f, a2 = 0.f, a3 = 0.f;
#pragma unroll
        for (int i = 0; i < 32; ++i) { const f32x4 s = sk[i]; a0 += s.x * w[i].x; a1 += s.y * w[i].y; a2 += s.z * w[i].z; a3 += s.w * w[i].w; }
        F.WqT[(size_t)(hp * 128 + n) * D + k] = (bf16)f2bf(((a0 + a1) + (a2 + a3)) * gk);
    }
}
__device__ __forceinline__ void p0_prologue(Frame& F) {
    LAS float* scr = (LAS float*)(F.lds + RING_OFF + F.wave * 16384);
    const int gw = F.vcu * NWAVES + F.wave, NGW = F.G * NWAVES;
    if (!(F.wave & 1)) {
    for (int rep = 0; rep < 1 + ((DBG_P0REP >> 0) & 1); ++rep)
    for (int it = gw; it < 2048; it += NGW) p0_fold_task(F, it);
    }
    constexpr int I_IN = (D / 64) * (NIN / 32), I_R = (RW / 64) * (D / 32), I_C = (CCH / 64) * (D / 32), I_O = (D / 64) * (D / 32);
    constexpr int NITEMS = I_IN + I_R + I_C + I_O;
    for (int rep = 0; rep < 1 + ((DBG_P0REP >> 1) & 1); ++rep)
    for (int it = gw; it < NITEMS; it += NGW) {
        int r = it;
        if (r < I_IN) {
            if (P1_FP8 && (r % (NIN / 32)) * 32 >= P1_NB) p0_transpose_item<true, P1_SB>(F.w_in, D, NIN, (bf16*)F.WinT8, scr, r, F.lane, P1_NB); else p0_transpose_item(F.w_in, D, NIN, F.WinT, scr, r, F.lane);
            continue; } r -= I_IN;
        if (r < I_R) { p0_transpose_item(F.w_ret_proj, RW, D, F.WrT, scr, r, F.lane); continue; } r -= I_R;
        if (r < I_C) { p0_transpose_item(F.w_conv_proj, CCH, D, F.WcT, scr, r, F.lane); continue; } r -= I_C;
        p0_transpose_item<P6_FP8, P6_SB>(F.w_out, D, D, F.WoT, scr, r, F.lane);
    }
    for (int rep = 0; rep < 1 + ((DBG_P0REP >> 2) & 1); ++rep)
    for (int m = gw * 4; m < M; m += NGW * 4) rms_rows_to_bf16<4, P1_FP8, P1_SA>(F.lane, F.x + (size_t)m * D, F.rms_mix_g, F.XN + (size_t)m * D, F.XN8 + (size_t)m * D);
    for (int rep = 0; rep < 1 + ((DBG_P0REP >> 3) & 1); ++rep)
    for (int r0 = gw * 4; r0 < 2 * NEXP; r0 += NGW * 4) {
        const bool isv = r0 >= NEXP; const int row0 = isv ? r0 - NEXP : r0;
        const float* base = (isv ? F.peer_v : F.peer_u) + (size_t)row0 * D;
        f32x4 v[4][4]; float ss[4];
#pragma unroll
        for (int r = 0; r < 4; ++r) { const f32x4* src = (const f32x4*)(base + (size_t)r * D) + 2 * F.lane;
            v[r][0] = src[0]; v[r][1] = src[1]; v[r][2] = src[128]; v[r][3] = src[129]; }
#pragma unroll
        for (int r = 0; r < 4; ++r) { float a = 0.f;
#pragma unroll
            for (int j = 0; j < 4; ++j) a += (v[r][j].x * v[r][j].x + v[r][j].y * v[r][j].y) + (v[r][j].z * v[r][j].z + v[r][j].w * v[r][j].w);
            ss[r] = a; }
#pragma unroll
        for (int o = 1; o < 64; o <<= 1) {
#pragma unroll
            for (int r = 0; r < 4; ++r) ss[r] += __shfl_xor(ss[r], o); }
#pragma unroll
        for (int r = 0; r < 4; ++r) {
            const float rms = ss[r] > 0.f ? sqrtf(ss[r] * (1.f / D)) : 1.0f;
            const float sc = 0.5f * rms, inv = 1.0f / sc;
            unsigned* dst = (unsigned*)(F.UT + (size_t)(row0 + r) * D + (isv ? D / 2 : 0)) + F.lane;
#pragma unroll
            for (int j = 0; j < 2; ++j) {
                const f32x4 a = v[r][2 * j], b = v[r][2 * j + 1];
                const float e[8] = {a.x, a.y, a.z, a.w, b.x, b.y, b.z, b.w}; unsigned w = 0u;
                w = __builtin_amdgcn_cvt_scalef32_pk_fp4_f32(w, e[0] * inv, e[1] * inv, 1.0f, 0);
                w = __builtin_amdgcn_cvt_scalef32_pk_fp4_f32(w, e[2] * inv, e[3] * inv, 1.0f, 1);
                w = __builtin_amdgcn_cvt_scalef32_pk_fp4_f32(w, e[4] * inv, e[5] * inv, 1.0f, 2);
                w = __builtin_amdgcn_cvt_scalef32_pk_fp4_f32(w, e[6] * inv, e[7] * inv, 1.0f, 3);
                dst[64 * j] = w;
            }
            if (F.lane == 0) ((_Float16*)F.USC)[2 * (row0 + r) + (isv ? 1 : 0)] = (_Float16)sc;
        }
    }
    {
        const size_t gt = (size_t)gw * 64 + F.lane, NT = (size_t)NGW * 64;
        for (size_t i = gt; i < (size_t)SEQ * 32; i += NT) {
            const int pos = (int)(i >> 5), fi = (int)(i & 31);
            double inv = 1.0; for (int j = 0; j < fi; ++j) inv *= 0.7498942093324559;
            double rev = (double)pos * inv * 0.15915494309189535; rev -= __builtin_floor(rev);
            const float r = (float)rev;
            F.ROPE[i] = (f32x2){__builtin_amdgcn_cosf(r), __builtin_amdgcn_sinf(r)};
        }
    }
    if (F.wave & 1) { for (int it = gw; it < 2048; it += NGW) p0_fold_task(F, it); }
}

__device__ __forceinline__ float lg2_gamma(int h) { return h == 0 ? -0.04580368961312479f : h == 1 ? -0.02272007650008353f : h == 2 ? -0.011315313227834146f : -0.005646563141142062f; }
__device__ __forceinline__ bf16x8 lds_frag(const LAS bf16* p) { return *(const LAS bf16x8*)p; }
#define MFMA16(a, b, c) __builtin_amdgcn_mfma_f32_16x16x32_bf16((a), (b), (c), 0, 0, 0)

__device__ __forceinline__ void rope8(const v4u a, const v4u b, const f32x4* rp4, float sc, float (&o1)[8], float (&o2)[8]) {
    const unsigned aw[4] = {a.x, a.y, a.z, a.w}, bw[4] = {b.x, b.y, b.z, b.w};
#pragma unroll
    for (int j = 0; j < 4; ++j) {
        const f32x4 cs = rp4[j];
        const float t1a = bflo(aw[j]), t1b = bfhi(aw[j]), t2a = bflo(bw[j]), t2b = bfhi(bw[j]);
        o1[2 * j] = (t1a * cs.x - t2a * cs.y) * sc; o2[2 * j] = (t1a * cs.y + t2a * cs.x) * sc;
        o1[2 * j + 1] = (t1b * cs.z - t2b * cs.w) * sc; o2[2 * j + 1] = (t1b * cs.w + t2b * cs.z) * sc;
    }
}

constexpr int KT_LD = 136, P2_KT = 0, P2_VT = 64 * KT_LD * 2;
struct P2Regs { v4u ka, kb; f32x4 rp[4]; v4u vv[4]; };
__device__ __forceinline__ void p2_state_load(Frame& F, int item, P2Regs& R) {
    const int h = item & 3, c = (item >> 2) & 31, b = item >> 7, t0 = b * SEQ + c * RC, m = F.tid & 127, q = F.tid >> 7;
    const bf16* krow = F.KH + ((size_t)item * 128 + m) * RDK;
    R.ka = *(const v4u*)(krow + q * 8); R.kb = *(const v4u*)(krow + 32 + q * 8);
    const f32x4* rp4 = (const f32x4*)(F.ROPE + (size_t)(c * RC + m) * 32 + q * 8);
#pragma unroll
    for (int j = 0; j < 4; ++j) R.rp[j] = rp4[j];
    const bf16* vrow = F.VH + ((size_t)item * 128 + m) * RDV + q * 32;
#pragma unroll
    for (int i = 0; i < 4; ++i) R.vv[i] = *(const v4u*)(vrow + i * 8);
}
__device__ __forceinline__ void p2_state_stage(Frame& F, int item, const P2Regs& R) {
    const int h = item & 3, m = F.tid & 127, q = F.tid >> 7;
    LAS bf16* KT = (LAS bf16*)(F.lds + P2_KT); LAS bf16* VT = (LAS bf16*)(F.lds + P2_VT);
    float o1[8], o2[8];
    rope8(R.ka, R.kb, R.rp, 0.125f * __builtin_amdgcn_exp2f(lg2_gamma(h) * (float)(127 - m)), o1, o2);
#pragma unroll
    for (int j = 0; j < 8; ++j) { KT[(q * 8 + j) * KT_LD + m] = (bf16)f2bf(o1[j]); KT[(q * 8 + j + 32) * KT_LD + m] = (bf16)f2bf(o2[j]); }
#pragma unroll
    for (int i = 0; i < 4; ++i) { const unsigned vw[4] = {R.vv[i].x, R.vv[i].y, R.vv[i].z, R.vv[i].w};
#pragma unroll
        for (int j = 0; j < 4; ++j) { VT[(q * 32 + i * 8 + 2 * j) * KT_LD + m] = (bf16)(vw[j] & 0xffffu); VT[(q * 32 + i * 8 + 2 * j + 1) * KT_LD + m] = (bf16)(vw[j] >> 16); } }
}
__device__ __forceinline__ void p2_state_compute(Frame& F, int item) {
    LAS bf16* KT = (LAS bf16*)(F.lds + P2_KT); LAS bf16* VT = (LAS bf16*)(F.lds + P2_VT);
    {
        const int w = F.wave, fr = F.lane & 15, fq = F.lane >> 4;
        f32x4 acc[4];
#pragma unroll
        for (int i = 0; i < 4; ++i) acc[i] = (f32x4){0.f, 0.f, 0.f, 0.f};
#pragma unroll
        for (int kk = 0; kk < 4; ++kk) {
            const bf16x8 bfrag = lds_frag(VT + (w * 16 + fr) * KT_LD + kk * 32 + fq * 8);
#pragma unroll
            for (int dkt = 0; dkt < 4; ++dkt) { const bf16x8 afrag = lds_frag(KT + (dkt * 16 + fr) * KT_LD + kk * 32 + fq * 8); acc[dkt] = MFMA16(afrag, bfrag, acc[dkt]); }
        }
        bf16* sp = F.S + (size_t)item * (RDV * RDK) + (size_t)(w * 16 + fr) * RDK + fq * 4;
#pragma unroll
        for (int dkt = 0; dkt < 4; ++dkt) { v2u o; o.x = pk2(acc[dkt][0], acc[dkt][1]); o.y = pk2(acc[dkt][2], acc[dkt][3]); *(v2u*)(sp + dkt * 16) = o; }
    }
}

constexpr int CV_TOK = 64, CV_ROWS = CV_TOK + CK - 1, P2_CT = 0, P2_YT = CV_ROWS * CCH * 2;
static_assert(P2_YT + 16 * CCH * 4 <= RING_BYTES, "conv LDS");
__device__ __forceinline__ void p2_conv_item(Frame& F, int ct) {
    const int t0 = ct * CV_TOK, s0 = t0 % SEQ;
    LAS bf16* CT = (LAS bf16*)(F.lds + P2_CT); LAS float* YT = (LAS float*)(F.lds + P2_YT);
    {
        constexpr int NIT = (CV_ROWS * (CCH / 8) + NWAVES * 64 - 1) / (NWAVES * 64);
        v4u uv[NIT], ug[NIT];
#pragma unroll
        for (int i = 0; i < NIT; ++i) {
            const int e = F.tid + i * NWAVES * 64, r = e >> 6, cg = e & 63;
            uv[i] = (v4u){0u, 0u, 0u, 0u}; ug[i] = (v4u){0u, 0u, 0u, 0u};
            if (e < CV_ROWS * (CCH / 8) && s0 + r - (CK - 1) >= 0) {
                const bf16* prow = F.PROJ + (size_t)(t0 + r - (CK - 1)) * NUVG;
                uv[i] = *(const v4u*)(prow + C_UV + cg * 8); ug[i] = *(const v4u*)(prow + C_UG + cg * 8);
            }
        }
#pragma unroll
        for (int i = 0; i < NIT; ++i) {
            const int e = F.tid + i * NWAVES * 64, r = e >> 6, cg = e & 63;
            if (e < CV_ROWS * (CCH / 8)) {
                v4u o;
                o.x = pk2(bflo(uv[i].x) * sigm(bflo(ug[i].x)), bfhi(uv[i].x) * sigm(bfhi(ug[i].x)));
                o.y = pk2(bflo(uv[i].y) * sigm(bflo(ug[i].y)), bfhi(uv[i].y) * sigm(bfhi(ug[i].y)));
                o.z = pk2(bflo(uv[i].z) * sigm(bflo(ug[i].z)), bfhi(uv[i].z) * sigm(bfhi(ug[i].z)));
                o.w = pk2(bflo(uv[i].w) * sigm(bflo(ug[i].w)), bfhi(uv[i].w) * sigm(bfhi(ug[i].w)));
                *(LAS v4u*)(CT + r * CCH + cg * 8) = o;
            }
        }
    }
    const int ch = F.tid;
    float wt[CK];
#pragma unroll
    for (int j = 0; j < CK; ++j) wt[j] = F.conv_dw_w[j * CCH + ch];
    const float bias = F.conv_dw_b[ch];
    __syncthreads();
    for (int st = 0; st < CV_TOK / 16; ++st) {
        float win[16 + CK - 1];
#pragma unroll
        for (int r = 0; r < 16 + CK - 1; ++r) win[r] = bf1(CT[(st * 16 + r) * CCH + ch]);
#pragma unroll
        for (int i = 0; i < 16; ++i) { float y = bias;
#pragma unroll
            for (int j = 0; j < CK; ++j) y += win[i + j] * wt[j];
            YT[i * CCH + ch] = y; }
        __syncthreads();
#pragma unroll
        for (int rr = 0; rr < 2; ++rr) {
            const int i = F.wave + rr * 8;
            const f32x4 a = *(const LAS f32x4*)(YT + i * CCH + F.lane * 8), b2 = *(const LAS f32x4*)(YT + i * CCH + F.lane * 8 + 4);
            const float mean = wave_sum_dpp((a.x + a.y) + (a.z + a.w) + (b2.x + b2.y) + (b2.z + b2.w)) * (1.f / CCH);
            const f32x4 da = a - mean, db = b2 - mean;
            const float var = wave_sum_dpp((da.x * da.x + da.y * da.y) + (da.z * da.z + da.w * da.w) + (db.x * db.x + db.y * db.y) + (db.z * db.z + db.w * db.w)) * (1.f / CCH);
            const float rstd = 1.f / sqrtf(var + LN_EPS);
            const f32x4 g0 = *(const f32x4*)(F.conv_ln_g + F.lane * 8), g1 = *(const f32x4*)(F.conv_ln_g + F.lane * 8 + 4);
            const f32x4 e0 = *(const f32x4*)(F.conv_ln_b + F.lane * 8), e1 = *(const f32x4*)(F.conv_ln_b + F.lane * 8 + 4);
            f32x4 y0 = da * rstd * g0 + e0, y1 = db * rstd * g1 + e1;
            y0.x *= sigm(y0.x); y0.y *= sigm(y0.y); y0.z *= sigm(y0.z); y0.w *= sigm(y0.w);
            y1.x *= sigm(y1.x); y1.y *= sigm(y1.y); y1.z *= sigm(y1.z); y1.w *= sigm(y1.w);
            v4u o; o.x = pk2(y0.x, y0.y); o.y = pk2(y0.z, y0.w); o.z = pk2(y1.x, y1.y); o.w = pk2(y1.z, y1.w);
            *(v4u*)(F.CB + (size_t)(t0 + st * 16 + i) * CCH + F.lane * 8) = o;
        }
        __syncthreads();
    }
}

__device__ __forceinline__ void p3_scan(Frame& F) {
    const int NT = F.G * NWAVES * 64, gt = F.vcu * (NWAVES * 64) + F.tid;
    constexpr int PER = RDV * RDK / 2;
    for (int e = gt; e < BATCH * RH * PER; e += NT) {
        const int p = e % PER, h = (e / PER) & 3, b = e / (PER * RH);
        const float dec = __builtin_amdgcn_exp2f(lg2_gamma(h) * 128.0f);
        unsigned* sp = (unsigned*)F.S + ((size_t)(b * NCH) * RH + h) * PER + p;
        unsigned v[NCH];
#pragma unroll
        for (int c = 0; c < NCH; ++c) v[c] = sp[(size_t)c * RH * PER];
        float s0 = 0.f, s1 = 0.f;
#pragma unroll
        for (int c = 0; c < NCH; ++c) { sp[(size_t)c * RH * PER] = pk2(s0, s1); s0 = s0 * dec + bflo(v[c]); s1 = s1 * dec + bfhi(v[c]); }
    }
}

constexpr int QK_LD = 72, P4_QS = 0, P4_KS = P4_QS + 128 * QK_LD * 2, P4_VT = P4_KS + 128 * QK_LD * 2, P4_ST = P4_VT + 128 * KT_LD * 2, P4_PS = P4_ST + 128 * QK_LD * 2, P4_END = P4_PS + 128 * KT_LD * 2;
static_assert(P4_END <= RING_BYTES, "P4 LDS");
struct P4Regs { v4u qa, qb, ka, kb; f32x4 rp[4]; v4u vv[4]; v4u st[2]; v4u g[4]; };
__device__ __forceinline__ void p4_load(Frame& F, int item, P4Regs& R) {
    const int h = item & 3, c = (item >> 2) & 31, b = item >> 7, t0 = b * SEQ + c * RC, m = F.tid & 127, q = F.tid >> 7;
    const bf16* qrow = F.QH + ((size_t)item * 128 + m) * RDK; const bf16* krow = F.KH + ((size_t)item * 128 + m) * RDK;
    R.qa = *(const v4u*)(qrow + q * 8); R.qb = *(const v4u*)(qrow + 32 + q * 8);
    R.ka = *(const v4u*)(krow + q * 8); R.kb = *(const v4u*)(krow + 32 + q * 8);
    const f32x4* rp4 = (const f32x4*)(F.ROPE + (size_t)(c * RC + m) * 32 + q * 8);
#pragma unroll
    for (int j = 0; j < 4; ++j) R.rp[j] = rp4[j];
    const bf16* vrow = F.VH + ((size_t)item * 128 + m) * RDV + q * 32;
#pragma unroll
    for (int i = 0; i < 4; ++i) R.vv[i] = *(const v4u*)(vrow + i * 8);
    const bf16* sp = F.S + (size_t)item * (RDV * RDK);
#pragma unroll
    for (int i = 0; i < 2; ++i) { const int pc = F.tid + i * 512, dv = pc >> 3, d8 = pc & 7; R.st[i] = *(const v4u*)(sp + dv * RDK + d8 * 8); }
    { const int n = F.wave * 16 + (F.lane >> 2), d0 = (F.lane & 3) * 32; const bf16* grow = F.GH + ((size_t)item * 128 + n) * RDV + d0;
#pragma unroll
      for (int i = 0; i < 4; ++i) R.g[i] = *(const v4u*)(grow + i * 8); }
}
__device__ __forceinline__ void p4_stage(Frame& F, int item, const P4Regs& R) {
    const int h = item & 3;
    LAS bf16* QS = (LAS bf16*)(F.lds + P4_QS); LAS bf16* KS = (LAS bf16*)(F.lds + P4_KS); LAS bf16* VT = (LAS bf16*)(F.lds + P4_VT); LAS bf16* ST = (LAS bf16*)(F.lds + P4_ST);
    const float lg = lg2_gamma(h);
    const int m = F.tid & 127, q = F.tid >> 7;
    float o1[8], o2[8];
    {
        rope8(R.qa, R.qb, R.rp, __builtin_amdgcn_exp2f(lg * (float)(m + 1)), o1, o2);
        v4u w1, w2; w1.x = pk2(o1[0], o1[1]); w1.y = pk2(o1[2], o1[3]); w1.z = pk2(o1[4], o1[5]); w1.w = pk2(o1[6], o1[7]);
        w2.x = pk2(o2[0], o2[1]); w2.y = pk2(o2[2], o2[3]); w2.z = pk2(o2[4], o2[5]); w2.w = pk2(o2[6], o2[7]);
        *(LAS v4u*)(QS + m * QK_LD + q * 8) = w1; *(LAS v4u*)(QS + m * QK_LD + 32 + q * 8) = w2;
    }
    {
        rope8(R.ka, R.kb, R.rp, 0.125f * __builtin_amdgcn_exp2f(-lg * (float)(m + 1)), o1, o2);
        v4u w1, w2; w1.x = pk2(o1[0], o1[1]); w1.y = pk2(o1[2], o1[3]); w1.z = pk2(o1[4], o1[5]); w1.w = pk2(o1[6], o1[7]);
        w2.x = pk2(o2[0], o2[1]); w2.y = pk2(o2[2], o2[3]); w2.z = pk2(o2[4], o2[5]); w2.w = pk2(o2[6], o2[7]);
        *(LAS v4u*)(KS + m * QK_LD + q * 8) = w1; *(LAS v4u*)(KS + m * QK_LD + 32 + q * 8) = w2;
    }
#pragma unroll
    for (int i = 0; i < 4; ++i) { const unsigned vw[4] = {R.vv[i].x, R.vv[i].y, R.vv[i].z, R.vv[i].w};
#pragma unroll
        for (int j = 0; j < 4; ++j) { VT[(q * 32 + i * 8 + 2 * j) * KT_LD + m] = (bf16)(vw[j] & 0xffffu); VT[(q * 32 + i * 8 + 2 * j + 1) * KT_LD + m] = (bf16)(vw[j] >> 16); } }
#pragma unroll
    for (int i = 0; i < 2; ++i) { const int pc = F.tid + i * 512, dv = pc >> 3, d8 = pc & 7; *(LAS v4u*)(ST + dv * QK_LD + d8 * 8) = R.st[i]; }
}
__device__ __forceinline__ void p4_compute(Frame& F, int item, const v4u (&gpre)[4]) {
    const int h = item & 3, c = (item >> 2) & 31, b = item >> 7;
    const int t0 = b * SEQ + c * RC;
    LAS bf16* QS = (LAS bf16*)(F.lds + P4_QS); LAS bf16* KS = (LAS bf16*)(F.lds + P4_KS); LAS bf16* VT = (LAS bf16*)(F.lds + P4_VT);
    LAS bf16* ST = (LAS bf16*)(F.lds + P4_ST); LAS bf16* PS = (LAS bf16*)(F.lds + P4_PS);
    const int w = F.wave, fr = F.lane & 15, fq = F.lane >> 4;
    const int nkk = (w >> 1) + 1;
    {
        const bf16x8 qa0 = lds_frag(QS + (w * 16 + fr) * QK_LD + fq * 8), qa1 = lds_frag(QS + (w * 16 + fr) * QK_LD + 32 + fq * 8);
        for (int jt = 0; jt < 2 * nkk; ++jt) {
            f32x4 s = (f32x4){0.f, 0.f, 0.f, 0.f};
            if (jt <= w) {
                const bf16x8 kb0 = lds_frag(KS + (jt * 16 + fr) * QK_LD + fq * 8), kb1 = lds_frag(KS + (jt * 16 + fr) * QK_LD + 32 + fq * 8);
                s = MFMA16(qa0, kb0, s); s = MFMA16(qa1, kb1, s);
            }
            const int mcol = jt * 16 + fr;
#pragma unroll
            for (int r = 0; r < 4; ++r) { const int n = w * 16 + fq * 4 + r; PS[n * KT_LD + mcol] = (bf16)f2bf(n >= mcol ? s[r] : 0.f); }
        }
    }
    __syncthreads();
    f32x4 o[8];
    {
        const bf16x8 qa0 = lds_frag(QS + (w * 16 + fr) * QK_LD + fq * 8), qa1 = lds_frag(QS + (w * 16 + fr) * QK_LD + 32 + fq * 8);
#pragma unroll
        for (int jt = 0; jt < 8; ++jt) {
            f32x4 a = (f32x4){0.f, 0.f, 0.f, 0.f};
            a = MFMA16(qa0, lds_frag(ST + (jt * 16 + fr) * QK_LD + fq * 8), a);
            a = MFMA16(qa1, lds_frag(ST + (jt * 16 + fr) * QK_LD + 32 + fq * 8), a);
            for (int kk = 0; kk < nkk; ++kk) a = MFMA16(lds_frag(PS + (w * 16 + fr) * KT_LD + kk * 32 + fq * 8), lds_frag(VT + (jt * 16 + fr) * KT_LD + kk * 32 + fq * 8), a);
            o[jt] = a;
        }
    }
    float mean[4], rstd[4];
#pragma unroll
    for (int r = 0; r < 4; ++r) {
        float s = 0.f;
#pragma unroll
        for (int jt = 0; jt < 8; ++jt) s += o[jt][r];
        s = row16_sum(s);
        mean[r] = s * (1.f / RDV);
        float q2 = 0.f;
#pragma unroll
        for (int jt = 0; jt < 8; ++jt) { const float d = o[jt][r] - mean[r]; q2 += d * d; }
        q2 = row16_sum(q2);
        rstd[r] = 1.f / sqrtf(q2 * (1.f / RDV) + LN_EPS);
    }
    __syncthreads();
#pragma unroll
    for (int jt = 0; jt < 8; ++jt) { const float gg = F.ret_gn_g[h * RDV + jt * 16 + fr];
#pragma unroll
        for (int r = 0; r < 4; ++r) PS[(w * 16 + fq * 4 + r) * KT_LD + jt * 16 + fr] = (bf16)f2bf((o[jt][r] - mean[r]) * rstd[r] * gg); }
    __syncthreads();
    {
        const int n = w * 16 + (F.lane >> 2), d0 = (F.lane & 3) * 32;
        bf16* orow = F.RA + (size_t)(t0 + n) * RW + h * RDV + d0;
#pragma unroll
        for (int i = 0; i < 4; ++i) {
            const v4u y = *(const LAS v4u*)(PS + n * KT_LD + d0 + i * 8); const v4u g = gpre[i];
            const unsigned yw[4] = {y.x, y.y, y.z, y.w}, gw[4] = {g.x, g.y, g.z, g.w}; unsigned ow[4];
#pragma unroll
            for (int j = 0; j < 4; ++j) { const float ga = bflo(gw[j]), gb = bfhi(gw[j]); ow[j] = pk2(bflo(yw[j]) * ga * sigm(ga), bfhi(yw[j]) * gb * sigm(gb)); }
            *(v4u*)(orow + i * 8) = (v4u){ow[0], ow[1], ow[2], ow[3]};
        }
    }
    __syncthreads();
}

#if DBG_PROBE
__device__ __forceinline__ void dbg_probe(Frame& F, int stage) {
    const int gw = F.vcu * NWAVES + F.wave, NGW = F.G * NWAVES;
    for (int m = gw; m < M; m += NGW) {
        const size_t t = (size_t)m; const int lane = F.lane; bool bad = false;
        const int cls = (int)(t & 7);
        const void* prow = nullptr; int nvec = 0; int mode = 0;
        if (cls == 1) { prow = F.ROPE + (t % SEQ) * 32; nvec = 16; mode = 1; }
        else if (cls == 2 || cls == 3) { prow = F.S + (t >> 5) * 8192; nvec = 1024; }
        else if (cls >= 4) { prow = F.PROJ + t * NIN; nvec = 1536 / 8; mode = 2; }
        for (int i = lane; i < nvec; i += 64) { const v4u w = ((const v4u*)prow)[i]; const unsigned ww[4] = {w.x, w.y, w.z, w.w};
#pragma unroll
            for (int j = 0; j < 4; ++j) {
                if (mode == 0) bad |= ((ww[j] & 0x7f80u) == 0x7f80u) | ((ww[j] & 0x7f800000u) == 0x7f800000u);
                else if (mode == 1) bad |= ((ww[j] & 0x7f800000u) == 0x7f800000u);
                else bad |= ((ww[j] & 0x7f80u) >= (133u << 7)) | ((ww[j] & 0x7f800000u) >= (133u << 23)); } }
        bad = __any(bad);
        if (lane == 0) ((unsigned*)((unsigned char*)F.UT - 1 * MiB))[t] = bad ? 1u : 0u;
    }
}
#endif
constexpr int P9_VR = DBG_P9_VR;
constexpr int P9_TOK = 64, P9_IDX = 0, P9_CQ = P9_IDX + 128 * 128 * 2, P9_CINV = P9_CQ + 128 * 128, P9_GU = P9_CINV + 512, P9_LUT = P9_GU + P9_TOK * 128 * 4, P9_ZP = P9_LUT  , P9_HROW = P9_ZP + P9_TOK * 128 * 4, P9_IMG = P9_GU, P9_IMG_BLK = 520, P9_IMG_W = 16 * P9_IMG_BLK,
              P9_GV = (P9_IMG + NWAVES * P9_IMG_W > P9_HROW + NWAVES * 512 ? P9_IMG + NWAVES * P9_IMG_W : P9_HROW + NWAVES * 512), P9_ZERO = P9_GV + 2 * D * 4, P9_END = P9_ZERO + 512;
static_assert(P9_END <= RING_BYTES && P9_LUT + 512 * 32 <= P9_HROW, "P9 LDS");
__device__ __forceinline__ unsigned mono16(unsigned hb) { return (hb & 0x8000u) ? (~hb & 0xffffu) : (hb | 0x8000u); }
__device__ __forceinline__ float unmono16(unsigned m) { const unsigned hb = (m & 0x8000u) ? (m & 0x7fffu) : (~m & 0xffffu); return (float)__builtin_bit_cast(_Float16, (unsigned short)hb); }
#define CE(a, b) do { const unsigned _h = (a) > (b) ? (a) : (b), _l = (a) > (b) ? (b) : (a); (a) = _h; (b) = _l; } while (0)
__device__ __forceinline__ void sort16_desc(unsigned (&K)[16]) {
    CE(K[0], K[1]); CE(K[2], K[3]); CE(K[0], K[2]); CE(K[1], K[3]); CE(K[1], K[2]); CE(K[4], K[5]);
    CE(K[6], K[7]); CE(K[4], K[6]); CE(K[5], K[7]); CE(K[5], K[6]); CE(K[0], K[4]); CE(K[2], K[6]);
    CE(K[2], K[4]); CE(K[1], K[5]); CE(K[3], K[7]); CE(K[3], K[5]); CE(K[1], K[2]); CE(K[3], K[4]);
    CE(K[5], K[6]); CE(K[8], K[9]); CE(K[10], K[11]); CE(K[8], K[10]); CE(K[9], K[11]); CE(K[9], K[10]);
    CE(K[12], K[13]); CE(K[14], K[15]); CE(K[12], K[14]); CE(K[13], K[15]); CE(K[13], K[14]); CE(K[8], K[12]);
    CE(K[10], K[14]); CE(K[10], K[12]); CE(K[9], K[13]); CE(K[11], K[15]); CE(K[11], K[13]); CE(K[9], K[10]);
    CE(K[11], K[12]); CE(K[13], K[14]); CE(K[0], K[8]); CE(K[4], K[12]); CE(K[4], K[8]); CE(K[2], K[10]);
    CE(K[6], K[14]); CE(K[6], K[10]); CE(K[2], K[4]); CE(K[6], K[8]); CE(K[10], K[12]); CE(K[1], K[9]);
    CE(K[5], K[13]); CE(K[5], K[9]); CE(K[3], K[11]); CE(K[7], K[15]); CE(K[7], K[11]); CE(K[3], K[5]);
    CE(K[7], K[9]); CE(K[11], K[13]); CE(K[1], K[2]); CE(K[3], K[4]); CE(K[5], K[6]); CE(K[7], K[8]);
    CE(K[9], K[10]); CE(K[11], K[12]); CE(K[13], K[14]);
}
__device__ __forceinline__ void merge16_desc(unsigned (&T)[16], const unsigned (&S)[16]) {
#pragma unroll
    for (int i = 0; i < 16; ++i) T[i] = T[i] > S[15 - i] ? T[i] : S[15 - i];
    CE(T[0], T[8]); CE(T[1], T[9]); CE(T[2], T[10]); CE(T[3], T[11]); CE(T[4], T[12]); CE(T[5], T[13]); CE(T[6], T[14]); CE(T[7], T[15]);
    CE(T[0], T[4]); CE(T[1], T[5]); CE(T[2], T[6]); CE(T[3], T[7]); CE(T[8], T[12]); CE(T[9], T[13]); CE(T[10], T[14]); CE(T[11], T[15]);
    CE(T[0], T[2]); CE(T[1], T[3]); CE(T[4], T[6]); CE(T[5], T[7]); CE(T[8], T[10]); CE(T[9], T[11]); CE(T[12], T[14]); CE(T[13], T[15]);
    CE(T[0], T[1]); CE(T[2], T[3]); CE(T[4], T[5]); CE(T[6], T[7]); CE(T[8], T[9]); CE(T[10], T[11]); CE(T[12], T[13]); CE(T[14], T[15]);
}
#undef CE
__device__ __forceinline__ void topk_list(const unsigned short* s, unsigned (&L)[16]) {
#pragma unroll
    for (int j = 0; j < 16; ++j) L[j] = 0u;
    v4u w0 = *(const v4u*)(s), w1 = *(const v4u*)(s + 8);
#pragma unroll 1
    for (int c = 0; c < 8; ++c) {
        const unsigned ww[8] = {w0.x, w0.y, w0.z, w0.w, w1.x, w1.y, w1.z, w1.w};
        if (c < 7) { w0 = *(const v4u*)(s + (c + 1) * 16); w1 = *(const v4u*)(s + (c + 1) * 16 + 8); }
        unsigned S[16];
#pragma unroll
        for (int e = 0; e < 16; ++e) { const unsigned hb = (ww[e >> 1] >> (16 * (e & 1))) & 0xffffu; S[e] = (mono16(hb) << 16) | (unsigned)(127 - (c * 16 + e)); }
        sort16_desc(S); merge16_desc(L, S);
    }
}
__device__ __forceinline__ unsigned msum(float f) { const unsigned u = __builtin_bit_cast(unsigned, f); return (u & 0x80000000u) ? ~u : (u | 0x80000000u); }
__device__ __forceinline__ float gelu_erf(float v) {
    const float av = __builtin_fabsf(v), t = __builtin_amdgcn_rcpf(av * 0.2316418882f + 1.0f);
    float q = t * 0.5307027145f + (-0.7265760135f); q = q * t + 0.7107068705f; q = q * t + (-0.142248368f); q = q * t + 0.127414796f; q = q * t;
    const float e = __builtin_amdgcn_exp2f((v * v) * (-0.72134752044f));
    const float m = v * (q * e);
    return v < 0.f ? m : v - m;
}
__device__ __forceinline__ void p9_topk(Frame& F, const size_t t0, const int lt0) {
    LAS unsigned short* IDXS = (LAS unsigned short*)(F.lds + P9_IDX) + lt0 * 128; LAS unsigned* GU = (LAS unsigned*)(F.lds + P9_GU); LAS _Float16* GUH = (LAS _Float16*)GU;
    {
        int tidv = F.tid; asm volatile("" : "+v"(tidv));
        const int tl = tidv >> 3, hd = tidv & 7;
        const unsigned short* srow = F.SC + (t0 + tl) * NSC + hd * PQ;
        unsigned L1[16], L2[16];
        topk_list(srow, L1); topk_list(srow + 128, L2);
        LAS unsigned* lut = (LAS unsigned*)(F.lds + P9_LUT) + tidv * 8;
        float v1[16], v2[16];
#pragma unroll
        for (int i = 0; i < 16; ++i) { v1[i] = unmono16(L1[i] >> 16); v2[i] = unmono16(L2[i] >> 16); }
#pragma unroll
        for (int i = 0; i < 4; ++i) {
            lut[i] = (127u - (L1[4 * i] & 0xffu)) | ((127u - (L1[4 * i + 1] & 0xffu)) << 8) | ((127u - (L1[4 * i + 2] & 0xffu)) << 16) | ((127u - (L1[4 * i + 3] & 0xffu)) << 24);
            lut[4 + i] = (127u - (L2[4 * i] & 0xffu)) | ((127u - (L2[4 * i + 1] & 0xffu)) << 8) | ((127u - (L2[4 * i + 2] & 0xffu)) << 16) | ((127u - (L2[4 * i + 3] & 0xffu)) << 24);
        }
        unsigned R[16];
#pragma unroll
        for (int j = 0; j < 16; ++j) R[j] = 0u;
#define CAND(i, j) ((msum(v1[i] + v2[j]) & 0xffffff00u) | (unsigned)(255 - ((i) * 16 + (j))))
        { unsigned S[16] = {CAND(0, 0), CAND(0, 1), CAND(0, 2), CAND(0, 3), CAND(0, 4), CAND(0, 5), CAND(0, 6), CAND(0, 7), CAND(0, 8), CAND(0, 9), CAND(0, 10), CAND(0, 11), CAND(0, 12), CAND(0, 13), CAND(0, 14), CAND(0, 15)}; sort16_desc(S); merge16_desc(R, S); }
        { unsigned S[16] = {CAND(1, 0), CAND(1, 1), CAND(1, 2), CAND(1, 3), CAND(1, 4), CAND(1, 5), CAND(1, 6), CAND(1, 7), CAND(2, 0), CAND(2, 1), CAND(2, 2), CAND(2, 3), CAND(2, 4), CAND(3, 0), CAND(3, 1), CAND(3, 2)}; sort16_desc(S); merge16_desc(R, S); }
        { unsigned S[16] = {CAND(3, 3), CAND(4, 0), CAND(4, 1), CAND(4, 2), CAND(5, 0), CAND(5, 1), CAND(6, 0), CAND(6, 1), CAND(7, 0), CAND(7, 1), CAND(8, 0), CAND(9, 0), CAND(10, 0), CAND(11, 0), CAND(12, 0), CAND(13, 0)}; sort16_desc(S); merge16_desc(R, S); }
        { unsigned S[16] = {CAND(14, 0), CAND(15, 0), 0u, 0u, 0u, 0u, 0u, 0u, 0u, 0u, 0u, 0u, 0u, 0u, 0u, 0u}; sort16_desc(S); merge16_desc(R, S); }
#undef CAND
        const LAS unsigned char* lb = (const LAS unsigned char*)lut;
        float wv[16], vs[16], wsum = 0.f, vmax = 0.f;
#pragma unroll
        for (int r = 0; r < 16; ++r) {
            const unsigned key = R[r], mk = key & 0xffffff00u;
            const float val = __builtin_bit_cast(float, (mk & 0x80000000u) ? (mk & 0x7fffffffu) : ~mk);
            if (r == 0) vmax = val;
            wv[r] = __builtin_amdgcn_exp2f((val - vmax) * 1.4426950408889634f); wsum += wv[r];
            const unsigned pos = 255u - (key & 0xffu);
            const unsigned e1 = lb[pos >> 4], e2 = lb[16 + (pos & 15u)], ex = e1 * 128u + e2;
            IDXS[tl * 128 + hd * 16 + r] = (unsigned short)ex;
            const unsigned uv = ((const unsigned*)F.USC)[ex];
            ((LAS unsigned short*)GUH)[2 * (tl * 128 + hd * 16 + r)] = (unsigned short)(uv & 0xffffu); vs[r] = (float)__builtin_bit_cast(_Float16, (unsigned short)(uv >> 16));
        }
        const float inv = 1.0f / wsum;
#pragma unroll
        for (int r = 0; r < 16; ++r) GUH[2 * (tl * 128 + hd * 16 + r) + 1] = (_Float16)(wv[r] * inv * vs[r]);
    }
}
#define P9_EM (DBG_DUMMY_EMASK != 0 ? emask : 0xffff)
typedef int p9v8i __attribute__((ext_vector_type(8)));
typedef int p9v4i __attribute__((ext_vector_type(4)));
typedef int p9v2i __attribute__((ext_vector_type(2)));
__device__ __forceinline__ void p9_dots8(Frame& F, const size_t t0, const int lt0, const int gt0, const int rnd, const int emask) {
    int lanev = F.lane; asm volatile("" : "+v"(lanev));
    const int lane = lanev, lq = lane >> 4, ln = lane & 15;
    const LAS unsigned short* IDXS = (const LAS unsigned short*)(F.lds + P9_IDX) + lt0 * 128; const LAS unsigned* GU = (const LAS unsigned*)(F.lds + P9_GU) + gt0 * 128;
    LAS float* ZP = (LAS float*)(F.lds + P9_ZP) + gt0 * 128;
    LAS unsigned char* CQ = F.lds + P9_CQ + lt0 * 128; LAS float* CINV = (LAS float*)(F.lds + P9_CINV) + lt0;
    LAS unsigned char* hrow = F.lds + P9_HROW + F.wave * 512;
    const LAS unsigned char* habase = (lq == (ln >> 2) ? hrow + 16 * (ln & 3) : F.lds + P9_ZERO) + rnd * 256;
    const int dim0 = 16 * ln + 4 * lq;
    const int ucol = rnd * 256 + (lane & 3) * 16;
    const int zslot = 4 * lq + (ln >> 2);
    unsigned char* H4 = F.XN8; float* HS = (float*)(F.XN8 + (size_t)M * 512);
    v2u hw[4] = {{0u, 0u}, {0u, 0u}, {0u, 0u}, {0u, 0u}}; float sst = 0.f; v2u hqn = {0u, 0u}; float hsn = 0.f; p9v4i buf[4][4];
    {
#pragma unroll
        for (int b = 0; b < 4; ++b) { const int uo = ((int)IDXS[16 * b + (lane >> 2)] & P9_EM) * D + ucol;
#pragma unroll
            for (int s2 = 0; s2 < 4; ++s2) buf[b][s2] = *(const p9v4i*)(F.UT + (size_t)(unsigned)uo + s2 * 64);
        }
        if (rnd == 0) {
#pragma unroll
            for (int G = 0; G < 4; ++G) hw[G] = *(const v2u*)(F.X1 + t0 * D + 256 * G + dim0);
            sst = F.SS[t0 * 16 + ln]; }
        else { hqn = *(const v2u*)(H4 + t0 * 512 + lane * 8); hsn = HS[t0]; }
    }
#pragma unroll 1
    for (int it = 0; it < 8; ++it) {
        const int itn = it < 7 ? it + 1 : it;
        float hs;
        if (rnd != 0) { *(LAS v2u*)(hrow + lane * 8) = hqn; hs = hsn; }
        else
        {
            float s16 = sst;
            s16 = row16_sum(s16);
            const float rstd = 1.0f / sqrtf(s16 * (1.f / D) + RMS_EPS);
            float hf[16], sq = 0.f;
#pragma unroll
            for (int G = 0; G < 4; ++G) { const f32x4 g = *(const LAS f32x4*)(F.lds + P9_GV + (256 * G + dim0) * 4);
                hf[4 * G] = bflo(hw[G].x) * g.x * rstd; hf[4 * G + 1] = bfhi(hw[G].x) * g.y * rstd; hf[4 * G + 2] = bflo(hw[G].y) * g.z * rstd; hf[4 * G + 3] = bfhi(hw[G].y) * g.w * rstd;
                sq += (hf[4 * G] * hf[4 * G] + hf[4 * G + 1] * hf[4 * G + 1]) + (hf[4 * G + 2] * hf[4 * G + 2] + hf[4 * G + 3] * hf[4 * G + 3]); }
            const float hr = sqrtf(wave_sum_dpp(sq) * (1.f / D));
            const float qi = hr > 0.f ? 2.0f / hr : 0.f; hs = hr * 0.5f;
#pragma unroll
            for (int G = 0; G < 4; ++G) { unsigned p = 0u;
                p = __builtin_amdgcn_cvt_scalef32_pk_fp4_f32(p, hf[4 * G] * qi, hf[4 * G + 1] * qi, 1.0f, 0); p = __builtin_amdgcn_cvt_scalef32_pk_fp4_f32(p, hf[4 * G + 2] * qi, hf[4 * G + 3] * qi, 1.0f, 1);
                *(LAS unsigned short*)(hrow + 128 * G + (dim0 >> 1)) = (unsigned short)p; }
            *(v2u*)(H4 + (t0 + it) * 512 + lane * 8) = *(const LAS v2u*)(hrow + lane * 8); if (lane == 0) HS[t0 + it] = hs;
        }
        p9v4i hA[4];
#pragma unroll
        for (int s2 = 0; s2 < 4; ++s2) hA[s2] = *(const LAS p9v4i*)(habase + s2 * 64);
        float cval[8];
#pragma unroll
        for (int s = 0; s < 8; ++s) {
            const int bs = s & 3;
            {
                f32x4 zc = (f32x4){0.f, 0.f, 0.f, 0.f};
#pragma unroll
                for (int s2 = 0; s2 < 4; ++s2) {
                    const p9v8i tb = {buf[bs][s2].x, buf[bs][s2].y, buf[bs][s2].z, buf[bs][s2].w, 0, 0, 0, 0};
                    const p9v8i aa = {hA[s2].x, hA[s2].y, hA[s2].z, hA[s2].w, 0, 0, 0, 0};
                    zc = __builtin_amdgcn_mfma_scale_f32_16x16x128_f8f6f4(aa, tb, zc, 4, 4, 0, 0x7f7f7f7f, 0, 0x7f7f7f7f);
                }
                const int r = ln & 3; float zsel = r == 0 ? zc[0] : r == 1 ? zc[1] : r == 2 ? zc[2] : zc[3];
                zsel = quad_sum(zsel);
                if (rnd == 0) { if ((ln & 3) == 0) ZP[it * 128 + 16 * s + zslot] = zsel; cval[s] = 0.f; }
                else {
                    zsel += ZP[it * 128 + 16 * s + zslot];
                    const unsigned gu = GU[it * 128 + 16 * s + zslot];
                    const float usc = (float)__builtin_bit_cast(_Float16, (unsigned short)(gu & 0xffffu)), gv = (float)__builtin_bit_cast(_Float16, (unsigned short)(gu >> 16));
                    cval[s] = gelu_erf(zsel * hs * usc) * gv;
                }
            }
            { const int uo = ((int)IDXS[(s + 4 < 8 ? it : itn) * 128 + 16 * ((s + 4) & 7) + (lane >> 2)] & P9_EM) * D + ucol;
#pragma unroll
                for (int s2 = 0; s2 < 4; ++s2) buf[bs][s2] = *(const p9v4i*)(F.UT + (size_t)(unsigned)uo + s2 * 64);
            }
            if (s == 3) {
                if (rnd == 0) {
#pragma unroll
                    for (int G = 0; G < 4; ++G) hw[G] = *(const v2u*)(F.X1 + (t0 + itn) * D + 256 * G + dim0);
                    sst = F.SS[(t0 + itn) * 16 + ln]; }
                else { hqn = *(const v2u*)(H4 + (t0 + itn) * 512 + lane * 8); hsn = HS[t0 + itn]; }
            }
        }
        if (rnd != 0) {
            float cm = 0.f;
#pragma unroll
            for (int g = 0; g < 8; ++g) cm = fmaxf(cm, __builtin_fabsf(cval[g]));
            cm = wave_max_dpp(cm);
            const float cq = cm > 0.f ? 256.0f / cm : 0.f;
            v2u cw;
            { int p = __builtin_amdgcn_cvt_pk_fp8_f32(cval[0] * cq, cval[1] * cq, 0, false); p = __builtin_amdgcn_cvt_pk_fp8_f32(cval[2] * cq, cval[3] * cq, p, true); cw.x = (unsigned)p; }
            { int p = __builtin_amdgcn_cvt_pk_fp8_f32(cval[4] * cq, cval[5] * cq, 0, false); p = __builtin_amdgcn_cvt_pk_fp8_f32(cval[6] * cq, cval[7] * cq, p, true); cw.y = (unsigned)p; }
            if ((ln & 3) == 0) *(LAS v2u*)(CQ + it * 128 + (4 * lq + (ln >> 2)) * 8) = cw;
            if (lane == 0) CINV[it] = cm * (1.0f / 256.0f);
        }
    }
}
template <int NR  > __device__ __forceinline__ void p9_vsum8(Frame& F, const size_t t0, const int lt0, const int hf  , const int emask, const bool dummy) {
    constexpr int SPT = 8 / NR, NP = 4 / NR;
    int lanev = F.lane; asm volatile("" : "+v"(lanev));
    const int lane = lanev, lq = lane >> 4, ln = lane & 15;
    const LAS unsigned short* IDXS = (const LAS unsigned short*)(F.lds + P9_IDX) + lt0 * 128;
    const LAS unsigned char* CQ = F.lds + P9_CQ + lt0 * 128; const LAS float* CINV = (const LAS float*)(F.lds + P9_CINV) + lt0;
    LAS unsigned char* img = F.lds + P9_IMG + F.wave * P9_IMG_W;
    LAS unsigned char* wbase = img + (2 * (lane & 7)) * P9_IMG_BLK + (lane >> 3) * 8;
    LAS unsigned char* rbase = img + lane * 8;
    const int dim0 = 16 * ln + 4 * lq;
    const int vslot0 = 16 * ((lane >> 3) & 7);
    const int vcol = D / 2 + hf * (512 / NR) + (lane & 7) * 16;
    int scl[4];
#pragma unroll
    for (int m = 0; m < 4; ++m) scl[m] = (ln >> 2) == m ? (0x7f << (8 * (ln & 3))) : 0;
    p9v4i buf[2][8]; v2u hwc[4];
#pragma unroll
    for (int b = 0; b < 2; ++b) {
#pragma unroll
        for (int i = 0; i < 8; ++i) { const int vo = ((int)IDXS[vslot0 + 4 * (i >> 1) + 2 * b + (i & 1)] & P9_EM) * D + vcol;
            buf[b][i] = *(const p9v4i*)(F.UT + (size_t)(unsigned)vo); }
    }
#pragma unroll 1
    for (int it = 0; it < 8; ++it) {
        const int itn = it < 7 ? it + 1 : it; const size_t t = t0 + it;
        const p9v4i cb0 = *(const LAS p9v4i*)(CQ + it * 128 + 16 * lq), cb1 = *(const LAS p9v4i*)(CQ + it * 128 + 64 + 16 * lq);
        const p9v8i cb = {cb0.x, cb0.y, cb0.z, cb0.w, cb1.x, cb1.y, cb1.z, cb1.w};
        const float cinv = CINV[it];
        f32x4 acc[NP]; p9v2i trA[16];
#pragma unroll
        for (int G = 0; G < NP; ++G) acc[G] = (f32x4){0.f, 0.f, 0.f, 0.f};
#pragma unroll
        for (int s = 0; s < SPT; ++s) {
            const int bs = s & 1;
#pragma unroll
            for (int i = 0; i < 8; ++i) {
                *(LAS p9v2i*)(wbase + 64 * i) = (p9v2i){buf[bs][i].x, buf[bs][i].y};
                *(LAS p9v2i*)(wbase + P9_IMG_BLK + 64 * i) = (p9v2i){buf[bs][i].z, buf[bs][i].w};
            }
            { const int vs = (s + 2) % SPT, tk = s + 2 < SPT ? it : itn;
#pragma unroll
                for (int i = 0; i < 8; ++i) { const int vo = ((int)IDXS[tk * 128 + vslot0 + 4 * (i >> 1) + 2 * (vs & 1) + (i & 1)] & P9_EM) * D + vcol + (vs >> 1) * 128;
                    buf[bs][i] = *(const p9v4i*)(F.UT + (size_t)(unsigned)vo); }
            }
            if (s == 1) {
#pragma unroll
                for (int G = 0; G < 4; ++G) hwc[G] = *(const v2u*)(F.X1 + t * D + 256 * G + dim0);
            }
            const int Pl = s >> 1;
            if ((s & 1) == 0) {
#pragma unroll
                for (int bb = 0; bb < 16; ++bb) trA[bb] = __builtin_amdgcn_ds_read_tr4_b64_v2i32((LAS p9v2i*)(rbase + bb * P9_IMG_BLK));
            } else {
                p9v2i trB[16];
#pragma unroll
                for (int bb = 0; bb < 16; ++bb) trB[bb] = __builtin_amdgcn_ds_read_tr4_b64_v2i32((LAS p9v2i*)(rbase + bb * P9_IMG_BLK));
#define P9_VBLK(bb, OPS) { const p9v8i aa = {trA[bb].x, trA[bb].y, trB[bb].x, trB[bb].y, 0, 0, 0, 0}; \
                acc[Pl] = __builtin_amdgcn_mfma_scale_f32_16x16x128_f8f6f4(aa, cb, acc[Pl], 4, 0, 0, 0x7f7f7f7f, OPS, scl[(bb) >> 2]); }
                P9_VBLK(0, 0) P9_VBLK(1, 1) P9_VBLK(2, 2) P9_VBLK(3, 3) P9_VBLK(4, 0) P9_VBLK(5, 1) P9_VBLK(6, 2) P9_VBLK(7, 3)
                P9_VBLK(8, 0) P9_VBLK(9, 1) P9_VBLK(10, 2) P9_VBLK(11, 3) P9_VBLK(12, 0) P9_VBLK(13, 1) P9_VBLK(14, 2) P9_VBLK(15, 3)
#undef P9_VBLK
            }
        }
        f32x4 r[4];
#pragma unroll
        for (int G = 0; G < 4; ++G) r[G] = (f32x4){bflo(hwc[G].x), bfhi(hwc[G].x), bflo(hwc[G].y), bfhi(hwc[G].y)};
        if (hf < NR - 1) {
#pragma unroll
            for (int Pl = 0; Pl < NP; ++Pl) { f32x4 y;
                if (NP == 1) y = hf == 0 ? r[0] : hf == 1 ? r[1] : r[2]; else y = r[Pl];
#if DBG_OUT == 0
                y += acc[Pl] * cinv;
#endif
                v2u o; o.x = pk2(y.x, y.y); o.y = pk2(y.z, y.w); if (!dummy) *(v2u*)(F.X1 + t * D + 256 * (hf * NP + Pl) + dim0) = o; }
            continue;
        }
        float* orow = F.out + t * D;
        float ss = 0.f;
#pragma unroll
        for (int G = 0; G < 4; ++G) { const int off = 256 * G + dim0;
#if DBG_OUT == 0
            if (G >= 4 - NP) r[G] += acc[G - (4 - NP)] * cinv;
#endif
#if DBG_OUT == 1
            r[G] = *(const f32x4*)(F.x + t * D + off);
#endif
#if DBG_SAN
            r[G].x = (__builtin_fabsf(r[G].x) < 1e30f) ? r[G].x : 0.f; r[G].y = (__builtin_fabsf(r[G].y) < 1e30f) ? r[G].y : 0.f; r[G].z = (__builtin_fabsf(r[G].z) < 1e30f) ? r[G].z : 0.f; r[G].w = (__builtin_fabsf(r[G].w) < 1e30f) ? r[G].w : 0.f;
#endif
            ss += (r[G].x * r[G].x + r[G].y * r[G].y) + (r[G].z * r[G].z + r[G].w * r[G].w); }
        const float rstd = 1.f / sqrtf(wave_sum_dpp(ss) * (1.f / D) + RMS_EPS);
        if (dummy) { if (lane == 0) ((float*)((unsigned char*)F.SS + 4 * MiB))[t] = rstd; continue; }
#pragma unroll
        for (int G = 0; G < 4; ++G) { const int off = 256 * G + dim0; const f32x4 g = *(const LAS f32x4*)(F.lds + P9_GV + D * 4 + off * 4);
            *(f32x4*)(orow + off) = r[G] * rstd * g; }
    }
}
__device__ __forceinline__ void p9_phase(Frame& F, const int emask = 0x3fff, const bool dummy = false) {
    ((LAS f32x2*)(F.lds + P9_GV))[F.tid] = ((const f32x2*)F.rms_ffn_g)[F.tid]; ((LAS f32x2*)(F.lds + P9_GV + D * 4))[F.tid] = ((const f32x2*)F.rms_final_g)[F.tid];
    if (F.tid < 128) ((LAS unsigned*)(F.lds + P9_ZERO))[F.tid] = 0u;
    const int ntile = M / P9_TOK;
    for (int tile0 = F.vcu; tile0 < ntile; tile0 += 2 * F.G) {
        __syncthreads();
        for (int j = 0; j < 2; ++j) { const int tile = tile0 + j * F.G; if (tile >= ntile) break;
            p9_topk(F, (size_t)tile * P9_TOK, j * P9_TOK);
            __syncthreads();
            for (int rnd = 0; rnd < 2; ++rnd) p9_dots8(F, (size_t)tile * P9_TOK + F.wave * 8, j * P9_TOK + F.wave * 8, F.wave * 8, rnd, emask);
            __syncthreads();
        }
        for (int rnd = 0; rnd < P9_VR; ++rnd)
        for (int j = 0; j < 2; ++j) { const int tile = tile0 + j * F.G; if (tile >= ntile) break;
            p9_vsum8<P9_VR>(F, (size_t)tile * P9_TOK + F.wave * 8, j * P9_TOK + F.wave * 8, rnd, emask, dummy);
        }
    }
    __syncthreads();
}

struct Args { const float* in[18]; float* out; unsigned char* ws; int ph_lo, ph_hi; };
__global__ void __launch_bounds__(NWAVES * 64, 2) mk_fwd(Args args) {
    extern __shared__ __attribute__((aligned(16))) unsigned char lds[];
    Frame F;
    F.lds = (LAS unsigned char*)lds;
    F.MISC = (volatile LAS unsigned*)(F.lds + MISC_OFF);
    F.wave = __builtin_amdgcn_readfirstlane((int)threadIdx.x >> 6); F.lane = mk_lane(); F.tid = F.wave * 64 + F.lane;
    F.G = gridDim.x; { const int bx = blockIdx.x; F.vcu = (F.G % 8 == 0) ? (bx % 8) * (F.G / 8) + bx / 8 : bx; }
    unsigned char* ws = args.ws;
    F.ctl = (gu32*)(ws + WS_CTL);
    F.x = args.in[0]; F.rms_mix_g = args.in[1]; F.w_in = args.in[2]; F.ret_gn_g = args.in[3]; F.conv_dw_w = args.in[4]; F.conv_dw_b = args.in[5]; F.conv_ln_g = args.in[6]; F.conv_ln_b = args.in[7];
    F.w_ret_proj = args.in[8]; F.w_conv_proj = args.in[9]; F.b_conv_proj = args.in[10]; F.w_out = args.in[11]; F.rms_ffn_g = args.in[12]; F.w_query = args.in[13]; F.sub_keys = args.in[14];
    F.peer_u = args.in[15]; F.peer_v = args.in[16]; F.rms_final_g = args.in[17]; F.out = args.out;
    F.ROPE = (f32x2*)(ws + WS_ROPE); F.WinT = (bf16*)(ws + WS_WIN); F.WrT = (bf16*)(ws + WS_WR); F.WcT = (bf16*)(ws + WS_WC); F.WoT = (bf16*)(ws + WS_WO); F.WqT = (bf16*)(ws + WS_WQ);
    F.UT = ws + WS_UT; F.XN8 = ws + WS_XN8; F.WinT8 = ws + WS_WIN8; F.VT = ws + WS_VT; F.USC = (float*)(ws + WS_USC); F.VSC = (float*)(ws + WS_VSC); F.XN = (bf16*)(ws + WS_XN); F.PROJ = (bf16*)(ws + WS_PROJ); F.S = (bf16*)(ws + WS_S);
    F.RA = (bf16*)args.out; F.CB = (bf16*)args.out + (size_t)M * RW; F.VH = (bf16*)args.out + (size_t)2 * M * RW; F.GH = (bf16*)args.out + (size_t)3 * M * RW; F.QH = (bf16*)(ws + WS_QH); F.KH = (bf16*)(ws + WS_KH); F.GTA = (bf16*)(ws + WS_GTA); F.GTB = (bf16*)(ws + WS_GTB); F.SC = (unsigned short*)(ws + WS_SC); F.X1 = (bf16*)(ws + WS_X1); F.SS = (float*)(ws + WS_SS);
    for (int u = F.tid; u < (LDS_BYTES - LDSCTL_OFF) / 4; u += NWAVES * 64) ((LAS unsigned*)(F.lds + LDSCTL_OFF))[u] = 0u;
    __syncthreads();
    XcdBarrier bar; bar.bar = (unsigned*)(F.ctl + CW_BAR); bar.x = 0; bar.st = nullptr;
    if (!MK_PER_PHASE) bar = xcd_barrier_post((unsigned*)(F.ctl + CW_BAR), F.MISC + 8, F.wave);
    const int lo = args.ph_lo, hi = args.ph_hi;
#define IN(k) (lo <= (k) && (k) < hi)
#define SEAM(k) do { if (IN(k) && hi > (k) + 1) { xcd_barrier(bar); if (DBG_DOUBLE_BAR) xcd_barrier(bar); } } while (0)
#define NREP(k) ((((DBG_REPEAT) >> (k)) & 1) + 1)

    if (IN(0)) { for (int rep = 0; rep < NREP(0); ++rep) { p0_prologue(F); if (rep + 1 < NREP(0)) { VM_WAIT(); __syncthreads(); } } SEAM(0); }
    if (IN(1)) {
        for (int rep = 0; rep < NREP(1); ++rep) {
        if constexpr (P1_FP8) {
            { pg8::Gemm g{F.XN, F.WinT, M, P1_NB, D}; pg8::StaticOrder S; S.init(M, P1_NB, F.G, (int)blockIdx.x);
              pg8::EpiProj E{F.PROJ, F.QH, F.KH, F.VH, F.GH, F.GTA, F.GTB, 0};
              pg8::gemm_phase<pg8::EpiProj, pg8::StaticOrder, PG8_ALIGN, PG8_SP2>(F.lds + RING_OFF, g, S, E, F.wave); }
            { pg8::Gemm g{(const bf16*)F.XN8, (const bf16*)F.WinT8, M, NIN - P1_NB, D}; pg8::StaticOrder S; S.init(M, NIN - P1_NB, F.G, (int)blockIdx.x);
              pg8::EpiProj E{F.PROJ, F.QH, F.KH, F.VH, F.GH, F.GTA, F.GTB, P1_NB / 256};
              pg8::gemm_phase<pg8::EpiProj, pg8::StaticOrder, PG8_ALIGN, PG8_SP2, true, P1_SA, P1_SB>(F.lds + RING_OFF, g, S, E, F.wave); }
        } else {
        pg8::Gemm g{F.XN, F.WinT, M, NIN, D}; pg8::StaticOrder S; S.init(M, NIN, F.G, (int)blockIdx.x);
        pg8::EpiProj E{F.PROJ, F.QH, F.KH, F.VH, F.GH, F.GTA, F.GTB, 0};
        pg8::gemm_phase<pg8::EpiProj, pg8::StaticOrder, PG8_ALIGN, PG8_SP2>(F.lds + RING_OFF, g, S, E, F.wave); }
        VM_WAIT(); __syncthreads(); }
        SEAM(1);
    }
    if (IN(2)) { F.lane = mk_lane(); F.tid = F.wave * 64 + F.lane;
        constexpr int NS = BATCH * NCH * RH, NC = M / CV_TOK;
        for (int rep = 0; rep < NREP(2); ++rep) {
        { P2Regs R; int it = F.vcu; if (it < NS) p2_state_load(F, it, R);
          for (; it < NS; it += F.G) { p2_state_stage(F, it, R); __syncthreads(); if (it + F.G < NS) p2_state_load(F, it + F.G, R); p2_state_compute(F, it); __syncthreads(); } }
        for (int rep2 = 0; rep2 < 1 + DBG_CONVREP; ++rep2)
        for (int it = F.vcu; it < NC; it += F.G) p2_conv_item(F, it);
        }
        SEAM(2);
    }
    if (IN(3)) { F.lane = mk_lane(); F.tid = F.wave * 64 + F.lane;
        p3_scan(F);
        SEAM(3); }
    if (IN(4)) { F.lane = mk_lane(); F.tid = F.wave * 64 + F.lane;
        for (int rep = 0; rep < NREP(4); ++rep) {
          constexpr int NI = BATCH * NCH * RH;
          P4Regs R; int it = F.vcu; if (it < NI) p4_load(F, it, R);
          for (; it < NI; it += F.G) {
              p4_stage(F, it, R); v4u gcur[4];
#pragma unroll
              for (int i = 0; i < 4; ++i) gcur[i] = R.g[i];
              __syncthreads();
              if (it + F.G < NI) p4_load(F, it + F.G, R);
              p4_compute(F, it, gcur);
          }
        }
        SEAM(4);
    }
    if (IN(5)) { F.lane = mk_lane(); F.tid = F.wave * 64 + F.lane;
#if DBG_PROBE
        dbg_probe(F, 1);
#endif
        for (int rep = 0; rep < NREP(5); ++rep) {
          pg8::Gemm g{F.CB, F.WcT, M, D, CCH, F.RA, F.WrT}; pg8::DualOrder S; S.init(M, D, F.G, (int)blockIdx.x);
          pg8::EpiGateChain E{F.XN, D, F.GTA, F.GTB, F.b_conv_proj};
          pg8::gemm_phase<pg8::EpiGateChain, pg8::DualOrder, PG8_ALIGN, PG8_SP2>(F.lds + RING_OFF, g, S, E, F.wave); VM_WAIT(); __syncthreads(); }
        SEAM(5);
    }
    if (IN(6)) { F.lane = mk_lane(); F.tid = F.wave * 64 + F.lane;
        for (int rep = 0; rep < NREP(6); ++rep) {
        pg8::Gemm g{F.XN, F.WoT, M, D, D}; pg8::StaticOrder S; S.init(M, D, F.G, (int)blockIdx.x);
        pg8::EpiResBf16SS E{F.X1, D, F.x, F.SS};
        pg8::gemm_phase<pg8::EpiResBf16SS, pg8::StaticOrder, PG8_ALIGN, PG8_SP2, P6_FP8, P6_SA, P6_SB>(F.lds + RING_OFF, g, S, E, F.wave);
        VM_WAIT(); __syncthreads(); }
        SEAM(6);
    }
    if (IN(8)) { F.lane = mk_lane(); F.tid = F.wave * 64 + F.lane;
        for (int rep = 0; rep < NREP(8); ++rep) {
        pg8::Gemm g{F.X1, F.WqT, M, NSC, D}; pg8::StaticOrder S; S.init(M, NSC, F.G, (int)blockIdx.x);
        pg8::EpiF16Rstd E{F.SC, NSC, F.SS, 1.0f / D, RMS_EPS};
        pg8::gemm_phase<pg8::EpiF16Rstd, pg8::StaticOrder, PG8_ALIGN, PG8_SP2>(F.lds + RING_OFF, g, S, E, F.wave);
        VM_WAIT(); __syncthreads(); }
        SEAM(8);
    }
    if (IN(9)) { F.lane = mk_lane(); F.tid = F.wave * 64 + F.lane;
#if DBG_DUMMY_EMASK
        p9_phase(F, DBG_DUMMY_EMASK, true);
#endif
        for (int rep = 0; rep < NREP(9); ++rep) p9_phase(F);
    }
#undef IN
#undef SEAM
}

extern "C" void kernel_launch(void* const* d_in, const int* in_sizes, int n_in, void* d_out, int out_size, void* d_ws, size_t ws_size, hipStream_t stream) {
    static int grid = 0;
    if (grid == 0) {
        if (n_in != 18 || in_sizes[0] != M * D || out_size != M * D || ws_size < WS_END) { fprintf(stderr, "kernel_launch: unexpected problem shape (n_in %d, in0 %d, out %d, ws %zu); nothing launched\n", n_in, n_in > 0 ? in_sizes[0] : -1, out_size, ws_size); grid = -1; return; }
        int dev = 0, cus = 0, per_cu = 0;
        if (hipGetDevice(&dev) != hipSuccess || hipDeviceGetAttribute(&cus, hipDeviceAttributeMultiprocessorCount, dev) != hipSuccess) { fprintf(stderr, "kernel_launch: device query failed\n"); grid = -1; return; }
        if (hipFuncSetAttribute((const void*)mk_fwd, hipFuncAttributeMaxDynamicSharedMemorySize, LDS_BYTES) != hipSuccess) { fprintf(stderr, "kernel_launch: hipFuncSetAttribute failed\n"); grid = -1; return; }
        if (hipOccupancyMaxActiveBlocksPerMultiprocessor(&per_cu, (const void*)mk_fwd, NWAVES * 64, LDS_BYTES) != hipSuccess || per_cu < 1) { fprintf(stderr, "kernel_launch: occupancy query reports %d workgroups per CU\n", per_cu); (void)hipGetLastError(); grid = -1; return; }
        grid = cus;
    }
    if (grid < 0) return;
    (void)hipMemsetAsync((char*)d_ws + WS_CTL, 0, CTL_ZERO_BYTES, stream);
    Args a{};
    for (int i = 0; i < 18; ++i) a.in[i] = (const float*)d_in[i];
    a.out = (float*)d_out; a.ws = (unsigned char*)d_ws;
#if MK_PER_PHASE
    for (int p = 0; p < N_PHASES; ++p) { if (!((DBG_PHASE_MASK >> p) & 1)) continue; a.ph_lo = p; a.ph_hi = p + 1; hipLaunchKernelGGL(mk_fwd, dim3(grid), dim3(NWAVES * 64), LDS_BYTES, stream, a); }
#else
    a.ph_lo = 0; a.ph_hi = N_PHASES;
    hipLaunchKernelGGL(mk_fwd, dim3(grid), dim3(NWAVES * 64), LDS_BYTES, stream, a);
#endif
    const hipError_t le = hipPeekAtLastError();
    if (le != hipSuccess) fprintf(stderr, "kernel_launch: launch failed: %s\n", hipGetErrorName(le));
}
```

```cpp
#include <hip/hip_runtime.h>
#include <cstdio>
#include <cstdint>
#ifndef P1_FP8
#define P1_FP8 true
#endif
constexpr int P1_SA = 3, P1_SB = 6, P1_NB = 1536;
#ifndef GATE_FP8
#define GLU_P1 true
#define GATE_FP8 true
#endif
#ifndef P6_FP8
#define P6_FP8 false
#endif
constexpr int P6_SA = 2, P6_SB = 6;
__device__ __forceinline__ int mk_lane() { int l; asm volatile("v_mbcnt_lo_u32_b32 %0, -1, 0\n\tv_mbcnt_hi_u32_b32 %0, -1, %0" : "=v"(l)); return l; }
namespace pg8 {
#define PG8_LAS __attribute__((address_space(3)))
typedef unsigned short bf16_t;
typedef short bf16x8 __attribute__((ext_vector_type(8)));
typedef int v4i_t __attribute__((ext_vector_type(4)));
typedef int v8i_t __attribute__((ext_vector_type(8)));
typedef float f32x4 __attribute__((ext_vector_type(4)));
typedef unsigned u32x4 __attribute__((ext_vector_type(4)));
typedef unsigned u32x2 __attribute__((ext_vector_type(2)));
constexpr int BM = 256, BK = 64, HALF = 128, HTB = HALF * BK * 2  , STAGE_BYTES = 8 * HTB, NXCD = 8, WGM = 8;

__host__ __device__ __forceinline__ int lds_byte(int r, int c) { const int st = (r >> 4) * 2 + (c >> 5), rr = r & 15, cc = c & 31, ob = rr * 64 + cc * 2; return st * 1024 + (ob ^ (((ob >> 9) & 1) << 5)); }
__host__ __device__ __forceinline__ void stage_rc(int b, int& R, int& C) { const int st = b / 1024, sb = b % 1024, swz = sb ^ (((sb >> 9) & 1) << 5); R = (st >> 1) * 16 + swz / 64; C = (st & 1) * 32 + (swz % 64) / 2; }
__host__ __device__ __forceinline__ int perm32(int rho) { const int n = rho >> 4, i = rho & 15; return 8 * (i >> 2) + 4 * n + (i & 3); }

struct Unit { int pm, pn, br; };
struct Gemm { const bf16_t* A; const bf16_t* Bt; int M, N, K; const bf16_t* A2; const bf16_t* Bt2; };

struct StaticOrder {
    int nM, nN, nwg, G, c;
    __host__ __device__ void init(int M, int N, int G_, int c_) { nM = M / BM; nN = N / BM; nwg = nM * nN; G = G_; c = c_; }
    __host__ __device__ bool next(int i, Unit& u) const {
        const long L = (long)i * G + c; if (L >= nwg) return false;
        int wgid = (int)L; { const int q = nwg / NXCD, r = nwg % NXCD, xcd = wgid % NXCD, off = wgid / NXCD; wgid = (xcd < r ? xcd * (q + 1) : r * (q + 1) + (xcd - r) * q) + off; }
        const int nig = WGM * nN, gid = wgid / nig, fm = gid * WGM, gsz = (nM - fm) < WGM ? (nM - fm) : WGM;
        u.pm = fm + ((wgid % nig) % gsz); u.pn = (wgid % nig) / gsz; u.br = 0; return true;
    }
    __device__ __forceinline__ void a_ready(const Unit&) const {}
    __device__ __forceinline__ void done(const Unit&) const {}
};
struct DualOrder : StaticOrder {
    __host__ __device__ bool next(int i, Unit& u) const { if (!StaticOrder::next(i >> 1, u)) return false; u.br = i & 1; return true; }
};

__device__ __forceinline__ unsigned cvt_pk_bf16(float lo, float hi) { typedef __bf16 bf16x2_t __attribute__((ext_vector_type(2))); bf16x2_t r; r.x = (__bf16)lo; r.y = (__bf16)hi; return __builtin_bit_cast(unsigned, r); }

__device__ __forceinline__ float bf_lo(unsigned w) { return __builtin_bit_cast(float, w << 16); }
__device__ __forceinline__ float bf_hi(unsigned w) { return __builtin_bit_cast(float, w & 0xffff0000u); }
__device__ __forceinline__ float sigmoidf_fast(float x) { return __builtin_amdgcn_rcpf(1.0f + __builtin_amdgcn_exp2f(-1.4426950408889634f * x)); }

struct EpiBf16Plain {
    static constexpr bool PERM = true, AFTER_DRAIN = false, CHAIN = false;
    bf16_t* O; int ldc;
    __device__ __forceinline__ void operator()(const f32x4 (&acc)[2][2][4][2], const Unit& u, int wr, int wc, int fr, int fq) const {
        const int row0 = u.pm * BM + wr * 64 + fr, col0 = u.pn * BM + wc * 32 + 8 * fq;
#pragma unroll
        for (int ai = 0; ai < 2; ++ai)
#pragma unroll
            for (int m = 0; m < 4; ++m) { bf16_t* rowp = O + (size_t)(row0 + ai * HALF + m * 16) * ldc + col0;
#pragma unroll
                for (int bj = 0; bj < 2; ++bj) { const f32x4 v0 = acc[ai][bj][m][0], v1 = acc[ai][bj][m][1];
                    u32x4 w; w.x = cvt_pk_bf16(v0[0], v0[1]); w.y = cvt_pk_bf16(v0[2], v0[3]); w.z = cvt_pk_bf16(v1[0], v1[1]); w.w = cvt_pk_bf16(v1[2], v1[3]);
                    *(u32x4*)(rowp + bj * HALF) = w; } }
    }
};
struct EpiF16Plain {
    static constexpr bool PERM = true, AFTER_DRAIN = false, CHAIN = false;
    unsigned short* O; int ldc;
    __device__ __forceinline__ static unsigned pkh(float a, float b) { typedef _Float16 h2 __attribute__((ext_vector_type(2))); h2 h; h.x = (_Float16)a; h.y = (_Float16)b; return __builtin_bit_cast(unsigned, h); }
    __device__ __forceinline__ void operator()(const f32x4 (&acc)[2][2][4][2], const Unit& u, int wr, int wc, int fr, int fq) const {
        const int row0 = u.pm * BM + wr * 64 + fr, col0 = u.pn * BM + wc * 32 + 8 * fq;
#pragma unroll
        for (int ai = 0; ai < 2; ++ai)
#pragma unroll
            for (int m = 0; m < 4; ++m) { unsigned short* rowp = O + (size_t)(row0 + ai * HALF + m * 16) * ldc + col0;
#pragma unroll
                for (int bj = 0; bj < 2; ++bj) { const f32x4 v0 = acc[ai][bj][m][0], v1 = acc[ai][bj][m][1];
                    u32x4 w; w.x = pkh(v0[0], v0[1]); w.y = pkh(v0[2], v0[3]); w.z = pkh(v1[0], v1[1]); w.w = pkh(v1[2], v1[3]);
                    *(u32x4*)(rowp + bj * HALF) = w; } }
    }
};
struct EpiGateA {
    static constexpr bool PERM = true, AFTER_DRAIN = false, CHAIN = false;
    bf16_t* T; int ldc; const bf16_t* G; int ldg;
    __device__ __forceinline__ void operator()(const f32x4 (&acc)[2][2][4][2], const Unit& u, int wr, int wc, int fr, int fq) const {
        const int row0 = u.pm * BM + wr * 64 + fr, col0 = u.pn * BM + wc * 32 + 8 * fq;
#pragma unroll
        for (int ai = 0; ai < 2; ++ai)
#pragma unroll
            for (int m = 0; m < 4; ++m) { const int row = row0 + ai * HALF + m * 16; bf16_t* rowp = T + (size_t)row * ldc + col0; const bf16_t* gp = G + (size_t)row * ldg + col0;
#pragma unroll
                for (int bj = 0; bj < 2; ++bj) { const f32x4 v0 = acc[ai][bj][m][0], v1 = acc[ai][bj][m][1];
                    const u32x4 g = *(const u32x4*)(gp + bj * HALF);
                    u32x4 w;
                    w.x = cvt_pk_bf16(v0[0] * sigmoidf_fast(bf_lo(g.x)), v0[1] * sigmoidf_fast(bf_hi(g.x)));
                    w.y = cvt_pk_bf16(v0[2] * sigmoidf_fast(bf_lo(g.y)), v0[3] * sigmoidf_fast(bf_hi(g.y)));
                    w.z = cvt_pk_bf16(v1[0] * sigmoidf_fast(bf_lo(g.z)), v1[1] * sigmoidf_fast(bf_hi(g.z)));
                    w.w = cvt_pk_bf16(v1[2] * sigmoidf_fast(bf_lo(g.w)), v1[3] * sigmoidf_fast(bf_hi(g.w)));
                    *(u32x4*)(rowp + bj * HALF) = w; } }
    }
};
struct EpiGateB {
    static constexpr bool PERM = true, AFTER_DRAIN = false, CHAIN = false;
    bf16_t* T; int ldc; const bf16_t* G; int ldg; const float* bias;
    __device__ __forceinline__ void operator()(const f32x4 (&acc)[2][2][4][2], const Unit& u, int wr, int wc, int fr, int fq) const {
        const int row0 = u.pm * BM + wr * 64 + fr, col0 = u.pn * BM + wc * 32 + 8 * fq;
        f32x4 bv[2][2];
#pragma unroll
        for (int bj = 0; bj < 2; ++bj)
#pragma unroll
            for (int n = 0; n < 2; ++n) bv[bj][n] = *(const f32x4*)(bias + col0 + bj * HALF + 4 * n);
#pragma unroll
        for (int ai = 0; ai < 2; ++ai)
#pragma unroll
            for (int m = 0; m < 4; ++m) { const int row = row0 + ai * HALF + m * 16; bf16_t* rowp = T + (size_t)row * ldc + col0; const bf16_t* gp = G + (size_t)row * ldg + col0;
#pragma unroll
                for (int bj = 0; bj < 2; ++bj) { const f32x4 v0 = acc[ai][bj][m][0] + bv[bj][0], v1 = acc[ai][bj][m][1] + bv[bj][1];
                    const u32x4 g = *(const u32x4*)(gp + bj * HALF);
                    const u32x4 t = *(const u32x4*)(rowp + bj * HALF);
                    u32x4 w;
                    w.x = cvt_pk_bf16(bf_lo(t.x) + v0[0] * sigmoidf_fast(bf_lo(g.x)), bf_hi(t.x) + v0[1] * sigmoidf_fast(bf_hi(g.x)));
                    w.y = cvt_pk_bf16(bf_lo(t.y) + v0[2] * sigmoidf_fast(bf_lo(g.y)), bf_hi(t.y) + v0[3] * sigmoidf_fast(bf_hi(g.y)));
                    w.z = cvt_pk_bf16(bf_lo(t.z) + v1[0] * sigmoidf_fast(bf_lo(g.z)), bf_hi(t.z) + v1[1] * sigmoidf_fast(bf_hi(g.z)));
                    w.w = cvt_pk_bf16(bf_lo(t.w) + v1[2] * sigmoidf_fast(bf_lo(g.w)), bf_hi(t.w) + v1[3] * sigmoidf_fast(bf_hi(g.w)));
                    *(u32x4*)(rowp + bj * HALF) = w; } }
    }
};
struct EpiResF32 {
    static constexpr bool PERM = false, AFTER_DRAIN = false, CHAIN = false;
    float* C; int ldc; const float* R;
    __device__ __forceinline__ void operator()(const f32x4 (&acc)[2][2][4][2], const Unit& u, int wr, int wc, int fr, int fq) const {
        const int row0 = u.pm * BM + wr * 64 + fr, col0 = u.pn * BM + wc * 32 + 4 * fq;
#pragma unroll
        for (int ai = 0; ai < 2; ++ai)
#pragma unroll
            for (int m = 0; m < 4; ++m) { const size_t off = (size_t)(row0 + ai * HALF + m * 16) * ldc + col0;
#pragma unroll
                for (int bj = 0; bj < 2; ++bj)
#pragma unroll
                    for (int n = 0; n < 2; ++n) *(f32x4*)(C + off + bj * HALF + n * 16) = acc[ai][bj][m][n] + *(const f32x4*)(R + off + bj * HALF + n * 16); }
    }
};
struct EpiResBf16SS {
    static constexpr bool PERM = true, AFTER_DRAIN = false, CHAIN = false;
    bf16_t* O; int ldc; const float* R; float* SS;
    __device__ __forceinline__ void operator()(const f32x4 (&acc)[2][2][4][2], const Unit& u, int wr, int wc, int fr, int fq) const {
        int upm = u.pm, upn = u.pn; asm volatile("" : "+s"(upm), "+s"(upn)); const int lnow = mk_lane(), frv = lnow & 15, fqv = lnow >> 4;
        const int row0 = upm * BM + wr * 64 + frv, col0 = upn * BM + wc * 32 + 8 * fqv;
#pragma unroll
        for (int ai = 0; ai < 2; ++ai)
#pragma unroll
            for (int m = 0; m < 4; ++m) { const int row = row0 + ai * HALF + m * 16; const size_t off = (size_t)row * ldc + col0; float ssq = 0.f;
#pragma unroll
                for (int bj = 0; bj < 2; ++bj) { const f32x4 v0 = acc[ai][bj][m][0] + __builtin_nontemporal_load((const f32x4*)(R + off + bj * HALF)), v1 = acc[ai][bj][m][1] + __builtin_nontemporal_load((const f32x4*)(R + off + bj * HALF + 4));
                    ssq += (v0[0] * v0[0] + v0[1] * v0[1]) + (v0[2] * v0[2] + v0[3] * v0[3]) + (v1[0] * v1[0] + v1[1] * v1[1]) + (v1[2] * v1[2] + v1[3] * v1[3]);
                    u32x4 w; w.x = cvt_pk_bf16(v0[0], v0[1]); w.y = cvt_pk_bf16(v0[2], v0[3]); w.z = cvt_pk_bf16(v1[0], v1[1]); w.w = cvt_pk_bf16(v1[2], v1[3]);
                    *(u32x4*)(O + off + bj * HALF) = w; }
                ssq += __shfl_xor(ssq, 16); ssq += __shfl_xor(ssq, 32);
                if (fqv == 0) SS[(size_t)row * 16 + upn * 4 + wc] = ssq; }
    }
};
struct EpiF16Rstd {
    static constexpr bool PERM = true, AFTER_DRAIN = false, CHAIN = false;
    unsigned short* O; int ldc; const float* SS; float inv_nd, eps;
    __device__ __forceinline__ static unsigned mono2(unsigned w) { typedef short s2 __attribute__((ext_vector_type(2))); const s2 sg = __builtin_bit_cast(s2, w) >> 15; return w ^ (__builtin_bit_cast(unsigned, sg) | 0x80008000u); }
    __device__ __forceinline__ void operator()(const f32x4 (&acc)[2][2][4][2], const Unit& u, int wr, int wc, int fr, int fq) const {
        const int row0 = u.pm * BM + wr * 64 + fr, col0 = u.pn * BM + wc * 32 + 8 * fq;
        f32x4 sq[8];
#pragma unroll
        for (int g = 0; g < 8; ++g) sq[g] = *(const f32x4*)(SS + (size_t)(row0 + (g >> 2) * HALF + (g & 3) * 16) * 16 + fq * 4);
        float rstd[8];
#pragma unroll
        for (int g = 0; g < 8; ++g) { float t = (sq[g][0] + sq[g][1]) + (sq[g][2] + sq[g][3]);
            t += __shfl_xor(t, 16); t += __shfl_xor(t, 32);
            rstd[g] = 1.0f / __builtin_sqrtf(t * inv_nd + eps); }
#pragma unroll
        for (int ai = 0; ai < 2; ++ai)
#pragma unroll
            for (int m = 0; m < 4; ++m) { const int row = row0 + ai * HALF + m * 16; const float rs = rstd[ai * 4 + m];
                unsigned short* rowp = O + ((((size_t)u.pn * ldc + (row >> 3)) * 2) * 8 + (wc * 2 + (fq >> 1))) * 128 + (row & 7) * 16 + 8 * (fq & 1);
#pragma unroll
                for (int bj = 0; bj < 2; ++bj) { const f32x4 v0 = acc[ai][bj][m][0] * rs, v1 = acc[ai][bj][m][1] * rs;
                    u32x4 w; w.x = mono2(EpiF16Plain::pkh(v0[0], v0[1])); w.y = mono2(EpiF16Plain::pkh(v0[2], v0[3])); w.z = mono2(EpiF16Plain::pkh(v1[0], v1[1])); w.w = mono2(EpiF16Plain::pkh(v1[2], v1[3]));
                    *(u32x4*)(rowp + bj * 1024) = w; } }
    }
};
struct EpiGateChain {
    static constexpr bool PERM = true, AFTER_DRAIN = false, CHAIN = true;
    bf16_t* T; int ldc; const bf16_t* GA; const bf16_t* GB; const float* bias;
    __device__ __forceinline__ static void gate8(const bf16_t* G, size_t off, float (&g)[8]) {
        if constexpr (GATE_FP8) { const u32x2 w = *(const u32x2*)((const unsigned char*)G + off);
            typedef float f2 __attribute__((ext_vector_type(2)));
            const f2 a = __builtin_amdgcn_cvt_pk_f32_fp8((int)w.x, false), b = __builtin_amdgcn_cvt_pk_f32_fp8((int)w.x, true), c = __builtin_amdgcn_cvt_pk_f32_fp8((int)w.y, false), d = __builtin_amdgcn_cvt_pk_f32_fp8((int)w.y, true);
            g[0] = a.x; g[1] = a.y; g[2] = b.x; g[3] = b.y; g[4] = c.x; g[5] = c.y; g[6] = d.x; g[7] = d.y; }
        else { const u32x4 w = *(const u32x4*)(G + off); g[0] = bf_lo(w.x); g[1] = bf_hi(w.x); g[2] = bf_lo(w.y); g[3] = bf_hi(w.y); g[4] = bf_lo(w.z); g[5] = bf_hi(w.z); g[6] = bf_lo(w.w); g[7] = bf_hi(w.w); }
    }
    __device__ __forceinline__ static u32x2 gate8_raw(const bf16_t* G, size_t off) { return *(const u32x2*)((const unsigned char*)G + off); }
    __device__ __forceinline__ static u32x2 gate8_raw_nt(const bf16_t* G, size_t off) { return __builtin_nontemporal_load((const u32x2*)((const unsigned char*)G + off)); }
    __device__ __forceinline__ static void gate8_dec(const u32x2 w, float (&g)[8]) {
        typedef float f2 __attribute__((ext_vector_type(2)));
        const f2 a = __builtin_amdgcn_cvt_pk_f32_fp8((int)w.x, false), b = __builtin_amdgcn_cvt_pk_f32_fp8((int)w.x, true), c = __builtin_amdgcn_cvt_pk_f32_fp8((int)w.y, false), d = __builtin_amdgcn_cvt_pk_f32_fp8((int)w.y, true);
        g[0] = a.x; g[1] = a.y; g[2] = b.x; g[3] = b.y; g[4] = c.x; g[5] = c.y; g[6] = d.x; g[7] = d.y; }
    __device__ __forceinline__ static float e_neg(float x) { return __builtin_amdgcn_exp2f(-1.4426950408889634f * fmaxf(x, -60.0f)); }
    __device__ __forceinline__ void mid(f32x4 (&acc)[2][2][4][2], const Unit& u, int wr, int wc, int fr, int fq) const {
        const int col0 = u.pn * BM + wc * 32 + 8 * fq;
        const size_t g0 = (size_t)(u.pm * 4 + u.pn) * 65536 + (size_t)(((wr * 4 + wc) * 64 + fq * 16 + fr) * 8);
        f32x4 bv[2][2];
#pragma unroll
        for (int bj = 0; bj < 2; ++bj)
#pragma unroll
            for (int n = 0; n < 2; ++n) bv[bj][n] = *(const f32x4*)(bias + col0 + bj * HALF + 4 * n);
        u32x2 gaw[16], gbw[16];
        if constexpr (GATE_FP8) {
#pragma unroll
            for (int p = 0; p < 16; ++p) { gaw[p] = gate8_raw(GA, g0 + (size_t)(p * 4096)); gbw[p] = gate8_raw_nt(GB, g0 + (size_t)(p * 4096)); } }
#pragma unroll
        for (int ai = 0; ai < 2; ++ai)
#pragma unroll
            for (int m = 0; m < 4; ++m) {
#pragma unroll
                for (int bj = 0; bj < 2; ++bj) { const size_t goff = g0 + (size_t)(((ai * 4 + m) * 2 + bj) * 4096);
                    float ga8[8], gb8[8];
                    if constexpr (GATE_FP8) { gate8_dec(gaw[(ai * 4 + m) * 2 + bj], ga8); gate8_dec(gbw[(ai * 4 + m) * 2 + bj], gb8); } else { gate8(GA, goff, ga8); gate8(GB, goff, gb8); }
#pragma unroll
                    for (int j = 0; j < 4; ++j) { const int n = j >> 1, c = 2 * (j & 1);
                        const float r0 = (1.0f + e_neg(ga8[2 * j])) * __builtin_amdgcn_rcpf(1.0f + e_neg(gb8[2 * j])), r1 = (1.0f + e_neg(ga8[2 * j + 1])) * __builtin_amdgcn_rcpf(1.0f + e_neg(gb8[2 * j + 1]));
                        acc[ai][bj][m][n][c] = (acc[ai][bj][m][n][c] + bv[bj][n][c]) * r0; acc[ai][bj][m][n][c + 1] = (acc[ai][bj][m][n][c + 1] + bv[bj][n][c + 1]) * r1; } } }
    }
    __device__ __forceinline__ void operator()(const f32x4 (&acc)[2][2][4][2], const Unit& u, int wr, int wc, int fr, int fq) const {
        const int row0 = u.pm * BM + wr * 64 + fr, col0 = u.pn * BM + wc * 32 + 8 * fq;
        const size_t g0 = (size_t)(u.pm * 4 + u.pn) * 65536 + (size_t)(((wr * 4 + wc) * 64 + fq * 16 + fr) * 8);
        u32x2 gw[16];
        if constexpr (GATE_FP8) {
#pragma unroll
            for (int p = 0; p < 16; ++p) gw[p] = gate8_raw_nt(GA, g0 + (size_t)(p * 4096)); }
#pragma unroll
        for (int ai = 0; ai < 2; ++ai)
#pragma unroll
            for (int m = 0; m < 4; ++m) { const int row = row0 + ai * HALF + m * 16; bf16_t* rowp = T + (size_t)row * ldc + col0;
#pragma unroll
                for (int bj = 0; bj < 2; ++bj) { const f32x4 v0 = acc[ai][bj][m][0], v1 = acc[ai][bj][m][1];
                    float g8[8]; if constexpr (GATE_FP8) gate8_dec(gw[(ai * 4 + m) * 2 + bj], g8); else gate8(GA, g0 + (size_t)(((ai * 4 + m) * 2 + bj) * 4096), g8);
                    const float o0 = v0[0] * __builtin_amdgcn_rcpf(1.0f + e_neg(g8[0])), o1 = v0[1] * __builtin_amdgcn_rcpf(1.0f + e_neg(g8[1])), o2 = v0[2] * __builtin_amdgcn_rcpf(1.0f + e_neg(g8[2])), o3 = v0[3] * __builtin_amdgcn_rcpf(1.0f + e_neg(g8[3]));
                    const float o4 = v1[0] * __builtin_amdgcn_rcpf(1.0f + e_neg(g8[4])), o5 = v1[1] * __builtin_amdgcn_rcpf(1.0f + e_neg(g8[5])), o6 = v1[2] * __builtin_amdgcn_rcpf(1.0f + e_neg(g8[6])), o7 = v1[3] * __builtin_amdgcn_rcpf(1.0f + e_neg(g8[7]));
                    if constexpr (P6_FP8) { constexpr float sc = (float)(1 << P6_SA);
                        int p0 = __builtin_amdgcn_cvt_pk_fp8_f32(o0 * sc, o1 * sc, 0, false); p0 = __builtin_amdgcn_cvt_pk_fp8_f32(o2 * sc, o3 * sc, p0, true);
                        int p1 = __builtin_amdgcn_cvt_pk_fp8_f32(o4 * sc, o5 * sc, 0, false); p1 = __builtin_amdgcn_cvt_pk_fp8_f32(o6 * sc, o7 * sc, p1, true);
                        *(u32x2*)((unsigned char*)T + (size_t)row * ldc + col0 + bj * HALF) = (u32x2){(unsigned)p0, (unsigned)p1}; }
                    else { u32x4 w; w.x = cvt_pk_bf16(o0, o1); w.y = cvt_pk_bf16(o2, o3); w.z = cvt_pk_bf16(o4, o5); w.w = cvt_pk_bf16(o6, o7);
                        *(u32x4*)(rowp + bj * HALF) = w; } } }
    }
};
struct EpiProj {
    static constexpr bool PERM = true, AFTER_DRAIN = false, CHAIN = false;
    bf16_t *UVG, *QH, *KH, *VH, *GH, *GTA, *GTB; int pn0;
    template <long SA, long SM, long SB> __device__ __forceinline__ static void store_all(const f32x4 (&acc)[2][2][4][2], bf16_t* p) {
#pragma unroll
        for (int ai = 0; ai < 2; ++ai) {
#pragma unroll
            for (int m = 0; m < 4; ++m) {
#pragma unroll
                for (int bj = 0; bj < 2; ++bj) { const f32x4 v0 = acc[ai][bj][m][0], v1 = acc[ai][bj][m][1];
                    u32x4 w; w.x = cvt_pk_bf16(v0[0], v0[1]); w.y = cvt_pk_bf16(v0[2], v0[3]); w.z = cvt_pk_bf16(v1[0], v1[1]); w.w = cvt_pk_bf16(v1[2], v1[3]);
                    *(u32x4*)(p + bj * SB) = w; }
                p += SM; asm volatile("" : "+v"(p)); }
            p += SA - 4 * SM; }
    }
    __device__ __forceinline__ static void store_glu(const f32x4 (&acc)[2][2][4][2], bf16_t* p) {
#pragma unroll
        for (int ai = 0; ai < 2; ++ai) {
#pragma unroll
            for (int m = 0; m < 4; ++m) { const f32x4 v0 = acc[ai][0][m][0], v1 = acc[ai][0][m][1], g0 = acc[ai][1][m][0], g1 = acc[ai][1][m][1];
                u32x4 w; w.x = cvt_pk_bf16(v0[0] * sigmoidf_fast(g0[0]), v0[1] * sigmoidf_fast(g0[1])); w.y = cvt_pk_bf16(v0[2] * sigmoidf_fast(g0[2]), v0[3] * sigmoidf_fast(g0[3]));
                w.z = cvt_pk_bf16(v1[0] * sigmoidf_fast(g1[0]), v1[1] * sigmoidf_fast(g1[1])); w.w = cvt_pk_bf16(v1[2] * sigmoidf_fast(g1[2]), v1[3] * sigmoidf_fast(g1[3]));
                *(u32x4*)p = w;
                p += 16L * 512; asm volatile("" : "+v"(p)); }
            p += (long)HALF * 512 - 4 * 16L * 512; }
    }
    __device__ __forceinline__ static void store_all8(unsigned char* p, const f32x4 (&acc)[2][2][4][2]) {
#pragma unroll
        for (int ai = 0; ai < 2; ++ai) {
#pragma unroll
            for (int m = 0; m < 4; ++m) {
#pragma unroll
                for (int bj = 0; bj < 2; ++bj) { const f32x4 v0 = acc[ai][bj][m][0], v1 = acc[ai][bj][m][1];
                    int p0 = __builtin_amdgcn_cvt_pk_fp8_f32(v0[0], v0[1], 0, false); p0 = __builtin_amdgcn_cvt_pk_fp8_f32(v0[2], v0[3], p0, true);
                    int p1 = __builtin_amdgcn_cvt_pk_fp8_f32(v1[0], v1[1], 0, false); p1 = __builtin_amdgcn_cvt_pk_fp8_f32(v1[2], v1[3], p1, true);
                    __builtin_nontemporal_store((u32x2){(unsigned)p0, (unsigned)p1}, (u32x2*)(p + bj * 4096)); }
                p += 8192; asm volatile("" : "+v"(p)); }
            p += 32768 - 4 * 8192; }
    }
    __device__ __forceinline__ void operator()(const f32x4 (&acc)[2][2][4][2], const Unit& u, int wr, int wc, int fr, int fq) const {
        int upm = u.pm, upn = u.pn + pn0; asm volatile("" : "+s"(upm), "+s"(upn)); const int lnow = mk_lane(), frv = lnow & 15, fqv = lnow >> 4;
        const int cl0 = wc * 32 + 8 * fqv, tok0 = wr * 64 + frv;
        const int item0 = ((upm >> 4) * 32 + 2 * (upm & 15)) * 4;
        if (upn >= 10) { if constexpr (GATE_FP8) store_all8((unsigned char*)(upn < 14 ? GTA : GTB) + (size_t)(upm * 4 + ((upn - 10) & 3)) * 65536 + (int)(((wr * 4 + wc) * 64 + fqv * 16 + frv) * 8), acc);
                         else store_all<32768L, 8192L, 4096L>(acc, (upn < 14 ? GTA : GTB) + (size_t)(upm * 4 + ((upn - 10) & 3)) * 65536 + (int)(((wr * 4 + wc) * 64 + fqv * 16 + frv) * 8)); }
        else if (GLU_P1 && upn >= 6) store_glu(acc, UVG + ((size_t)(upm * BM) * 512 + (upn - 6) * HALF) + (int)(tok0 * 512 + cl0));
        else if (upn >= 6) store_all<(long)HALF * 1024, 16L * 1024, (long)HALF>(acc, UVG + ((size_t)(upm * BM) * 1024 + (upn - 6) * BM) + (int)(tok0 * 1024 + cl0));
        else if (upn < 2) store_all<4L * 128 * 64, 16L * 64, 2L * 128 * 64>(acc, (upn == 0 ? QH : KH) + (size_t)item0 * 8192 + (int)(((cl0 >> 6) * 128 + tok0) * 64 + (cl0 & 63)));
        else store_all<4L * 128 * 128, 16L * 128, 128L * 128>(acc, (upn < 4 ? VH : GH) + (size_t)(item0 + (upn & 1) * 2) * 16384 + (int)(tok0 * 128 + cl0));
    }
};


template <class Epi, class Sched, bool ALIGN_EPI = false, bool SP2 = false, bool FP8 = false, int FP8_SA = 0, int FP8_SB = 0>
__device__ __forceinline__ void gemm_phase(PG8_LAS unsigned char* lds, const Gemm g, const Sched& S, const Epi& E, const int wid  ) {
    const int lane = mk_lane(), tid = wid * 64 + lane, wr = wid >> 2, wc = wid & 3, fr = lane & 15, fq = lane >> 4;
    const int K = g.K, KB = FP8 ? K : 2 * K  , nt = KB / (BK * 2);
    unsigned voffA, voffB;
    { int R, C; stage_rc(tid * 16, R, C); const int Rb = Epi::PERM ? ((R & ~31) + perm32(R & 31)) : R;
        voffA = (unsigned)(R * KB + C * 2); voffB = (unsigned)(Rb * KB + C * 2); }
    const size_t kstep = (size_t)(BK * 2);
    const size_t hstep = (size_t)HALF * KB;
    const size_t tstep = 2 * hstep;
    const unsigned ldsw = (unsigned)wid * 1024u;
    const int aoff = lds_byte(wr * 64 + fr, fq * 8), boff = lds_byte(wc * 32 + fr, fq * 8);
#define PG8_SA(b, h) (((b) * 2 + (h)) * HTB)
#define PG8_SB(b, h) ((4 + (b) * 2 + (h)) * HTB)
#define PG8_STAGE(bufoff, gbase, voff) do { _Pragma("unroll") for (int _i = 0; _i < 2; ++_i) \
        __builtin_amdgcn_global_load_lds((const unsigned*)((const char*)(gbase) + (size_t)_i * 64 * KB + (voff)), (PG8_LAS unsigned*)(lds + (bufoff) + ldsw + _i * 8192), 16, 0, 0); } while (0)
#define PG8_LDA(dst, b, h) do { _Pragma("unroll") for (int m = 0; m < 4; ++m) _Pragma("unroll") for (int k = 0; k < 2; ++k) dst[m][k] = *(const PG8_LAS bf16x8*)(lds + PG8_SA(b, h) + aoff + m * 2048 + k * 1024); } while (0)
#define PG8_LDB(dst, b, h) do { _Pragma("unroll") for (int n = 0; n < 2; ++n) _Pragma("unroll") for (int k = 0; k < 2; ++k) dst[n][k] = *(const PG8_LAS bf16x8*)(lds + PG8_SB(b, h) + boff + n * 2048 + k * 1024); } while (0)
#define PG8_MMA(ai, bj, At, Bt) do { __builtin_amdgcn_s_setprio(1); _Pragma("unroll") for (int m = 0; m < 4; ++m) _Pragma("unroll") for (int n = 0; n < 2; ++n) { \
        if constexpr (FP8) { const v4i_t b0 = __builtin_bit_cast(v4i_t, Bt[n][0]), b1 = __builtin_bit_cast(v4i_t, Bt[n][1]), a0 = __builtin_bit_cast(v4i_t, At[m][0]), a1 = __builtin_bit_cast(v4i_t, At[m][1]); \
            acc[ai][bj][m][n] = __builtin_amdgcn_mfma_scale_f32_16x16x128_f8f6f4(__builtin_shufflevector(b0, b1, 0, 1, 2, 3, 4, 5, 6, 7), __builtin_shufflevector(a0, a1, 0, 1, 2, 3, 4, 5, 6, 7), acc[ai][bj][m][n], 0, 0, \
                0, 0, 0, 0); }   \
        else { _Pragma("unroll") for (int k = 0; k < 2; ++k) acc[ai][bj][m][n] = __builtin_amdgcn_mfma_f32_16x16x32_bf16(Bt[n][k], At[m][k], acc[ai][bj][m][n], 0, 0, 0); } } __builtin_amdgcn_s_setprio(0); } while (0)
#define PG8_WAIT_V(n) asm volatile("s_waitcnt vmcnt(" #n ")" ::: "memory")
#define PG8_WAIT_L(n) asm volatile("s_waitcnt lgkmcnt(" #n ")" ::: "memory")
#define PG8_BAR __builtin_amdgcn_s_barrier()
#define PG8_SCHED __builtin_amdgcn_sched_barrier(0)
    Unit cur, nxt; int ui = 0;
    if (!S.next(0, cur)) return;
    f32x4 acc[2][2][4][2];
#pragma unroll
    for (int a = 0; a < 2; ++a)
#pragma unroll
        for (int b = 0; b < 2; ++b)
#pragma unroll
            for (int m = 0; m < 4; ++m)
#pragma unroll
                for (int n = 0; n < 2; ++n) acc[a][b][m][n] = (f32x4){0.f, 0.f, 0.f, 0.f};
    bf16x8 At[4][2], B0[2][2], B1[2][2];
    const char* cA = (const char*)(cur.br ? g.A2 : g.A) + (size_t)cur.pm * tstep; const char* cB = (const char*)(cur.br ? g.Bt2 : g.Bt) + (size_t)cur.pn * tstep;
    S.a_ready(cur);
    if constexpr (SP2) {
        PG8_STAGE(PG8_SB(0, 0), cB, voffB); PG8_STAGE(PG8_SB(0, 1), cB + hstep, voffB); PG8_STAGE(PG8_SA(0, 0), cA, voffA); PG8_STAGE(PG8_SA(0, 1), cA + hstep, voffA);
        if (wr == 1) PG8_BAR;
        PG8_WAIT_V(2); PG8_BAR;
        PG8_STAGE(PG8_SB(1, 0), cB + kstep, voffB); PG8_STAGE(PG8_SA(1, 0), cA + kstep, voffA); PG8_STAGE(PG8_SB(1, 1), cB + hstep + kstep, voffB);
        PG8_WAIT_V(6); PG8_BAR;
    } else {
        PG8_STAGE(PG8_SB(0, 0), cB, voffB); PG8_STAGE(PG8_SA(0, 0), cA, voffA); PG8_STAGE(PG8_SB(0, 1), cB + hstep, voffB); PG8_STAGE(PG8_SA(0, 1), cA + hstep, voffA);
        if (wr == 1) PG8_BAR;
        PG8_WAIT_V(4); PG8_BAR;
        PG8_STAGE(PG8_SB(1, 0), cB + kstep, voffB); PG8_STAGE(PG8_SA(1, 0), cA + kstep, voffA); PG8_STAGE(PG8_SB(1, 1), cB + hstep + kstep, voffB);
        PG8_WAIT_V(6); PG8_BAR;
    }
    for (;;) {
        const bool has_next = S.next(ui + 1, nxt);
        const char* nA = has_next ? (const char*)(nxt.br ? g.A2 : g.A) + (size_t)nxt.pm * tstep : cA; const char* nB = has_next ? (const char*)(nxt.br ? g.Bt2 : g.Bt) + (size_t)nxt.pn * tstep : cB;
#pragma unroll 1
        for (int t = 0; t < nt; t += 2) {
            const bool last = (t == nt - 2);
            const char* a1 = cA + (size_t)(t + 1) * kstep;
            const char* a2 = last ? nA : cA + (size_t)(t + 2) * kstep; const char* b2 = last ? nB : cB + (size_t)(t + 2) * kstep;
            const char* a3 = a2 + kstep; const char* b3 = b2 + kstep;
            if (last && has_next) S.a_ready(nxt);
            if constexpr (SP2) {
            PG8_LDB(B0, 0, 0); PG8_LDB(B1, 0, 1); PG8_SCHED; PG8_LDA(At, 0, 0); PG8_STAGE(PG8_SA(1, 1), a1 + hstep, voffA);
            PG8_WAIT_V(8); PG8_WAIT_L(0); PG8_BAR; PG8_MMA(0, 0, At, B0); PG8_MMA(0, 1, At, B1); PG8_BAR; PG8_SCHED;
            PG8_LDA(At, 0, 1); PG8_STAGE(PG8_SB(0, 0), b2, voffB); PG8_STAGE(PG8_SB(0, 1), b2 + hstep, voffB); PG8_STAGE(PG8_SA(0, 0), a2, voffA);
            PG8_WAIT_V(8); PG8_WAIT_L(0); PG8_BAR; PG8_MMA(1, 0, At, B0); PG8_MMA(1, 1, At, B1); PG8_BAR; PG8_SCHED;
            PG8_LDB(B0, 1, 0); PG8_LDB(B1, 1, 1); PG8_SCHED; PG8_LDA(At, 1, 0); PG8_STAGE(PG8_SA(0, 1), a2 + hstep, voffA);
            PG8_WAIT_V(8); PG8_WAIT_L(0); PG8_BAR; PG8_MMA(0, 0, At, B0); PG8_MMA(0, 1, At, B1); PG8_BAR; PG8_SCHED;
            PG8_LDA(At, 1, 1); PG8_STAGE(PG8_SB(1, 0), b3, voffB); PG8_STAGE(PG8_SB(1, 1), b3 + hstep, voffB); PG8_STAGE(PG8_SA(1, 0), a3, voffA);
            PG8_WAIT_V(8); PG8_WAIT_L(0); PG8_BAR; PG8_MMA(1, 0, At, B0); PG8_MMA(1, 1, At, B1); PG8_BAR; PG8_SCHED;
            } else {
            PG8_LDB(B0, 0, 0); PG8_SCHED; PG8_LDA(At, 0, 0); PG8_STAGE(PG8_SA(1, 1), a1 + hstep, voffA);
            PG8_WAIT_L(8); PG8_BAR; PG8_WAIT_L(0); PG8_MMA(0, 0, At, B0); PG8_BAR; PG8_SCHED;
            PG8_LDB(B1, 0, 1); PG8_STAGE(PG8_SB(0, 0), b2, voffB);
            PG8_BAR; PG8_WAIT_L(0); PG8_MMA(0, 1, At, B1); PG8_BAR;
            PG8_LDA(At, 0, 1); PG8_STAGE(PG8_SA(0, 0), a2, voffA);
            PG8_BAR; PG8_WAIT_L(0); PG8_MMA(1, 0, At, B0); PG8_BAR; PG8_SCHED;
            PG8_STAGE(PG8_SB(0, 1), b2 + hstep, voffB);
            PG8_WAIT_V(6); PG8_BAR; PG8_MMA(1, 1, At, B1); PG8_BAR;
            PG8_LDB(B0, 1, 0); PG8_SCHED; PG8_LDA(At, 1, 0); PG8_STAGE(PG8_SA(0, 1), a2 + hstep, voffA);
            PG8_WAIT_L(8); PG8_BAR; PG8_WAIT_L(0); PG8_MMA(0, 0, At, B0); PG8_BAR; PG8_SCHED;
            PG8_LDB(B1, 1, 1); PG8_STAGE(PG8_SB(1, 0), b3, voffB);
            PG8_BAR; PG8_WAIT_L(0); PG8_MMA(0, 1, At, B1); PG8_BAR;
            PG8_LDA(At, 1, 1); PG8_STAGE(PG8_SA(1, 0), a3, voffA);
            PG8_BAR; PG8_WAIT_L(0); PG8_MMA(1, 0, At, B0); PG8_BAR; PG8_SCHED;
            PG8_STAGE(PG8_SB(1, 1), b3 + hstep, voffB);
            PG8_WAIT_V(6); PG8_BAR; PG8_MMA(1, 1, At, B1); PG8_BAR;
            }
        }
        if constexpr (ALIGN_EPI) { if (wr == 0) PG8_BAR; }
        if constexpr (FP8) {
#pragma unroll
            for (int a = 0; a < 2; ++a)
#pragma unroll
                for (int b = 0; b < 2; ++b)
#pragma unroll
                    for (int m = 0; m < 4; ++m)
#pragma unroll
                        for (int n = 0; n < 2; ++n) acc[a][b][m][n] *= 1.0f / (float)(1 << (FP8_SA + FP8_SB));
        }
        bool carry = false;
        if constexpr (Epi::CHAIN) { if (cur.br == 0) { E.mid(acc, cur, wr, wc, fr, fq); carry = true; } else E(acc, cur, wr, wc, fr, fq); }
        else if constexpr (!Epi::AFTER_DRAIN) { E(acc, cur, wr, wc, fr, fq); S.done(cur); }
        if (!has_next) break;
        if (!carry)
#pragma unroll
        for (int a = 0; a < 2; ++a)
#pragma unroll
            for (int b = 0; b < 2; ++b)
#pragma unroll
                for (int m = 0; m < 4; ++m)
#pragma unroll
                    for (int n = 0; n < 2; ++n) acc[a][b][m][n] = (f32x4){0.f, 0.f, 0.f, 0.f};
        cur = nxt; cA = nA; cB = nB; ++ui;
        if constexpr (ALIGN_EPI) { if (wr == 1) PG8_BAR; }
    }
    PG8_WAIT_V(0);
    if constexpr (!ALIGN_EPI) { if (wr == 0) PG8_BAR; }
    PG8_BAR;
    if constexpr (Epi::AFTER_DRAIN) { E.fused(acc, cur, wr, wc, fr, fq, lds, wid, lane); S.done(cur); }
#undef PG8_SA
#undef PG8_SB
#undef PG8_STAGE
#undef PG8_LDA
#undef PG8_LDB
#undef PG8_MMA
#undef PG8_WAIT_V
#undef PG8_WAIT_L
#undef PG8_BAR
#undef PG8_SCHED
}
}

constexpr int NWAVES = 8;
#ifndef MK_PER_PHASE
#define MK_PER_PHASE 0
#endif
constexpr int N_PHASES = 10;
#ifndef DBG_OUT
#define DBG_OUT 0
#endif
#ifndef DBG_SAN
#define DBG_SAN 0
#endif
#ifndef DBG_PROBE
#define DBG_PROBE 0
#endif
#define DBG_P1 (F.PROJ + t * NIN)
#define DBG_N1 (NIN / 8)
#define DBG_P2 (F.RA + t * RW)
#define DBG_N2 (RW / 8)
#define DBG_P3 (F.CB + t * CCH)
#define DBG_N3 (CCH / 8)
#ifndef DBG_ZFILL
#define DBG_ZFILL 0
#endif
#ifndef DBG_PHASE_MASK
#define DBG_PHASE_MASK 0x3ff
#endif
#ifndef DBG_REPEAT
#define DBG_REPEAT 0
#endif
#ifndef DBG_P0REP
#define DBG_P0REP 0
#endif
#ifndef DBG_DOUBLE_BAR
#define DBG_DOUBLE_BAR 0
#endif
#ifndef DBG_CONVREP
#define DBG_CONVREP 0
#endif
#ifndef DBG_DUMMY_EMASK
#define DBG_DUMMY_EMASK 0
#endif
#ifndef DBG_P9_VR
#define DBG_P9_VR 4
#endif
#ifndef DBG_ZF
#define DBG_ZF 1.0f
#endif
#ifndef DBG_TOPKREP
#define DBG_TOPKREP 0
#endif
#ifndef DBG_PRIO9
#define DBG_PRIO9 0
#endif
#ifndef DBG_SKIP_AXPY
#define DBG_SKIP_AXPY 0
#endif
#ifndef PG8_SP2
#define PG8_SP2 true
#endif
#ifndef PG8_ALIGN
#define PG8_ALIGN true
#endif

constexpr int BATCH = 8, SEQ = 4096, D = 1024, M = BATCH * SEQ;
constexpr int RH = 4, RDK = 64, RDV = 128, RW = 512, RC = 128, NCH = SEQ / RC;
constexpr int CCH = 512, CK = 31;
constexpr int NIN = 4608, NUVG = 1024;
constexpr int C_UV = 0, C_UG = 512;
constexpr int PH = 8, PQ = 256, PHALF = 128, NKEY = 128, NEXP = 16384, TOPK = 16, NSC = 2048;
constexpr float RMS_EPS = 1e-6f, LN_EPS = 1e-5f;

constexpr size_t MiB = 1u << 20;
constexpr size_t WS_CTL = 0, CTL_ZERO_BYTES = 64 * 1024;
constexpr size_t WS_ROPE = 1 * MiB;
constexpr size_t WS_WIN = 2 * MiB, WS_WR = 11 * MiB, WS_WC = 12 * MiB, WS_WO = 13 * MiB, WS_WQ = 15 * MiB;
constexpr size_t WS_UT = 20 * MiB, WS_VT = 28 * MiB, WS_USC = 52 * MiB, WS_VSC = 52 * MiB + 65536;
constexpr size_t WS_XN = 84 * MiB;
constexpr size_t WS_PROJ = 148 * MiB, WS_GTA = 212 * MiB, WS_GTB = 276 * MiB;
constexpr size_t WS_SC = WS_PROJ, WS_X1 = WS_PROJ + 128 * MiB, WS_SS = WS_PROJ + 192 * MiB;
constexpr size_t WS_XN8 = 342 * MiB, WS_WIN8 = 374 * MiB;
constexpr size_t WS_S = 436 * MiB;
constexpr size_t WS_QH = 452 * MiB, WS_KH = 468 * MiB;
constexpr size_t WS_END = 500 * MiB;
constexpr int CW_TMO = 0, CW_CODE = 1, CW_BAR = 4096;

constexpr int RING_OFF = 0, RING_BYTES = 131072;
constexpr int LDSCTL_OFF = RING_BYTES, MISC_OFF = LDSCTL_OFF + 320;
constexpr int LDS_BYTES = 147456;
static_assert(MISC_OFF + 128 <= LDS_BYTES, "LDS map");

#define GAS __attribute__((address_space(1)))
#define LAS __attribute__((address_space(3)))
typedef unsigned short bf16;
typedef unsigned v4u __attribute__((ext_vector_type(4)));
typedef unsigned v2u __attribute__((ext_vector_type(2)));
typedef float f32x4 __attribute__((ext_vector_type(4)));
typedef float f32x2 __attribute__((ext_vector_type(2)));
typedef short bf16x8 __attribute__((ext_vector_type(8)));
typedef __bf16 bf16x2v __attribute__((ext_vector_type(2)));
typedef GAS unsigned gu32;
#define RLX_AGENT __ATOMIC_RELAXED, __HIP_MEMORY_SCOPE_AGENT
#define LDS_WAIT() asm volatile("s_waitcnt lgkmcnt(0)" ::: "memory")
#define VM_WAIT() asm volatile("s_waitcnt vmcnt(0)" ::: "memory")
#define LDS_BARRIER() do { asm volatile("s_waitcnt lgkmcnt(0)" ::: "memory"); __builtin_amdgcn_s_barrier(); asm volatile("" ::: "memory"); } while (0)
__device__ __forceinline__ unsigned f2bf(float f) { unsigned u = __builtin_bit_cast(unsigned, f); return (u + 0x7fffu + ((u >> 16) & 1u)) >> 16; }
__device__ __forceinline__ unsigned pk2(float lo, float hi) { return pg8::cvt_pk_bf16(lo, hi); }
__device__ __forceinline__ float bflo(unsigned w) { return __builtin_bit_cast(float, w << 16); }
__device__ __forceinline__ float bfhi(unsigned w) { return __builtin_bit_cast(float, w & 0xffff0000u); }
__device__ __forceinline__ float bf1(bf16 b) { return __builtin_bit_cast(float, (unsigned)b << 16); }
__device__ __forceinline__ float dot2bf(unsigned a, unsigned b, float acc) { return __builtin_amdgcn_fdot2_f32_bf16(__builtin_bit_cast(bf16x2v, a), __builtin_bit_cast(bf16x2v, b), acc, false); }
__device__ __forceinline__ float sigm(float x) { return __builtin_amdgcn_rcpf(1.0f + __builtin_amdgcn_exp2f(-1.4426950408889634f * x)); }
__device__ __forceinline__ float wave_sum(float v) {
#pragma unroll
    for (int o = 1; o < 64; o <<= 1) v += __shfl_xor(v, o);
    return v;
}

template <int CTRL, int RM = 0xf> __device__ __forceinline__ float dpp_get(float v) { return __builtin_bit_cast(float, __builtin_amdgcn_update_dpp(0, __builtin_bit_cast(int, v), CTRL, RM, 0xf, true)); }
__device__ __forceinline__ float quad_sum(float v) { v += dpp_get<0xB1>(v); v += dpp_get<0x4E>(v); return v; }
__device__ __forceinline__ float row16_sum(float v) { v = quad_sum(v); v += dpp_get<0x141>(v); v += dpp_get<0x140>(v); return v; }
__device__ __forceinline__ float wave_sum_dpp(float v) { v = row16_sum(v); v += dpp_get<0x142, 0xa>(v); v += dpp_get<0x143, 0xc>(v);
    return __builtin_bit_cast(float, __builtin_amdgcn_readlane(__builtin_bit_cast(int, v), 63)); }
__device__ __forceinline__ float wave_max_dpp(float v) {
    v = fmaxf(v, dpp_get<0xB1>(v)); v = fmaxf(v, dpp_get<0x4E>(v)); v = fmaxf(v, dpp_get<0x141>(v)); v = fmaxf(v, dpp_get<0x140>(v)); v = fmaxf(v, dpp_get<0x142, 0xa>(v)); v = fmaxf(v, dpp_get<0x143, 0xc>(v));
    return __builtin_bit_cast(float, __builtin_amdgcn_readlane(__builtin_bit_cast(int, v), 63)); }

#define XB_TMO      128
#define XB_XCNT(j)  (256  + 64 * (j))
#define XB_XSUB(j)  (1280 + 64 * (j))
#define XB_XGEN(j)  (2304 + 64 * (j))
#define XB_TOP      3328
#define XB_TOPGEN   3392
#define XCD_BAR_WORDS 3456
#define XB_SPIN_CAP (1u << 20)

__device__ __forceinline__ unsigned xb_ld(unsigned* p)              { return __hip_atomic_load(p, __ATOMIC_RELAXED, __HIP_MEMORY_SCOPE_AGENT); }
__device__ __forceinline__ unsigned xb_add(unsigned* p, unsigned v) { return __hip_atomic_fetch_add(p, v, __ATOMIC_RELAXED, __HIP_MEMORY_SCOPE_AGENT); }
__device__ __forceinline__ unsigned xb_xcc_id() { return (unsigned)__builtin_amdgcn_s_getreg((3 << 11) | 20) & 0xFu; }
#define XB_SPIN(cond, bar) do { unsigned _sp = 0; while (cond) { __builtin_amdgcn_s_sleep(1); \
    if ((++_sp & 255u) == 0u) { if (xb_ld(&(bar)[XB_TMO])) break; if (_sp > XB_SPIN_CAP) { atomicAdd(&(bar)[XB_TMO], 1u); break; } } } } while (0)

struct XcdBarrier { unsigned* bar; unsigned x; volatile LAS unsigned* st; int wave; };

__device__ __forceinline__ XcdBarrier xcd_barrier_post(unsigned* bar, volatile LAS unsigned* st, int wave) {
    XcdBarrier b; b.bar = bar; b.x = xb_xcc_id(); b.st = st; b.wave = wave;
    if (wave == 0 && mk_lane() == 0) (void)xb_add(&bar[XB_XCNT(b.x)], 1u);
    return b;
}
__device__ __forceinline__ void xcd_barrier_complete(unsigned* bar, unsigned x, unsigned& nloc, unsigned& nx) {
    const unsigned G = gridDim.x * gridDim.y * gridDim.z;
    unsigned sum, cnt, mine, sp = 0u;
    for (;;) {
        sum = 0u; cnt = 0u; mine = 0u;
#pragma unroll
        for (unsigned j = 0; j < 16; ++j) { const unsigned c = xb_ld(&bar[XB_XCNT(j)]); sum += c; cnt += (c > 0u) ? 1u : 0u; mine = (j == x) ? c : mine; }
        if (sum == G) break;
        __builtin_amdgcn_s_sleep(1);
        if ((++sp & 255u) == 0u) { if (xb_ld(&bar[XB_TMO])) break; if (sp > XB_SPIN_CAP) { atomicAdd(&bar[XB_TMO], 1u); break; } }
    }
    nloc = mine > 0u ? mine : 1u; nx = cnt > 0u ? cnt : 1u;
}
__device__ __forceinline__ void xcd_barrier(const XcdBarrier& b) {
    asm volatile("s_waitcnt vmcnt(0)" ::: "memory");
    __syncthreads();
    if (b.wave == 0 && mk_lane() == 0) {
        unsigned* bar = b.bar;
        __builtin_amdgcn_s_waitcnt(0);
        unsigned nloc = b.st[0], nx = b.st[1];
        if (nloc == 0u) { xcd_barrier_complete(bar, b.x, nloc, nx); b.st[0] = nloc; b.st[1] = nx; }
        const unsigned old = xb_add(&bar[XB_XSUB(b.x)], 1u);
        const unsigned gen = old / nloc;
        if (old + 1u == (gen + 1u) * nloc) {
            __builtin_amdgcn_fence(__ATOMIC_RELEASE, "agent");
            asm volatile("s_waitcnt vmcnt(0)" ::: "memory");
            const unsigned og = xb_add(&bar[XB_TOP], 1u);
            const unsigned tg = og / nx;
            if (og + 1u == (tg + 1u) * nx) xb_add(&bar[XB_TOPGEN], 1u);
            else XB_SPIN(xb_ld(&bar[XB_TOPGEN]) == tg, bar);
            __builtin_amdgcn_fence(__ATOMIC_ACQUIRE, "agent");
            xb_add(&bar[XB_XGEN(b.x)], 1u);
            asm volatile("s_waitcnt vmcnt(0)" ::: "memory");
        } else {
            XB_SPIN(xb_ld(&bar[XB_XGEN(b.x)]) == gen, bar);
            __builtin_amdgcn_fence(__ATOMIC_ACQUIRE, "agent");
            asm volatile("s_waitcnt vmcnt(0)" ::: "memory");
        }
    }
    __syncthreads();
}

struct Frame {
    LAS unsigned char* lds;
    volatile LAS unsigned* MISC;
    gu32* ctl;
    int tid, lane, wave;
    int vcu, G;
    const float *x, *rms_mix_g, *w_in, *ret_gn_g, *conv_dw_w, *conv_dw_b, *conv_ln_g, *conv_ln_b, *w_ret_proj, *w_conv_proj, *b_conv_proj, *w_out, *rms_ffn_g, *w_query, *sub_keys, *peer_u, *peer_v, *rms_final_g;
    float* out;
    f32x2* ROPE; bf16 *WinT, *WrT, *WcT, *WoT, *WqT, *XN, *PROJ, *S, *RA, *CB, *QH, *KH, *VH, *GH, *GTA, *GTB; unsigned char *UT, *VT, *XN8, *WinT8; float *USC, *VSC; unsigned short* SC; bf16* X1; float* SS;
};

template <bool FP8 = false, int SH = 0, bool GLU = false> __device__ __forceinline__ void p0_transpose_item(const float* W, int K, int N, bf16* WT, LAS float* scr, int item, int lane, int nsub = 0) {
    const int nblk = N / 32, kb = item / nblk, nb = item % nblk, k0 = 64 * kb, n0 = 32 * nb;
#pragma unroll 8
    for (int i = 0; i < 32; ++i) { const int kk = 2 * i + (lane >> 5); scr[kk * 33 + (lane & 31)] = __builtin_nontemporal_load(W + (size_t)(k0 + kk) * N + n0 + (lane & 31)); }
    LDS_WAIT(); asm volatile("" ::: "memory");
    const int c = lane & 7;
    int n0d = n0;
    if constexpr (GLU) { if (n0 >= 1536 && n0 < 2560) { const int o = n0 - 1536; n0d = 1536 + 256 * ((o & 511) >> 7) + 128 * (o >> 9) + (o & 127); } }
#pragma unroll
    for (int j = 0; j < 4; ++j) { const int n = (lane >> 3) + 8 * j; const LAS float* s = scr + (8 * c) * 33 + n;
        if constexpr (FP8) { constexpr float sc = (float)(1 << SH); v2u o;
            { int p = __builtin_amdgcn_cvt_pk_fp8_f32(s[0 * 33] * sc, s[1 * 33] * sc, 0, false); p = __builtin_amdgcn_cvt_pk_fp8_f32(s[2 * 33] * sc, s[3 * 33] * sc, p, true); o.x = (unsigned)p; }
            { int p = __builtin_amdgcn_cvt_pk_fp8_f32(s[4 * 33] * sc, s[5 * 33] * sc, 0, false); p = __builtin_amdgcn_cvt_pk_fp8_f32(s[6 * 33] * sc, s[7 * 33] * sc, p, true); o.y = (unsigned)p; }
            *(v2u*)((unsigned char*)WT + (size_t)(n0d + n - nsub) * K + k0 + 8 * c) = o; }
        else { v4u o; o.x = pk2(s[0 * 33], s[1 * 33]); o.y = pk2(s[2 * 33], s[3 * 33]); o.z = pk2(s[4 * 33], s[5 * 33]); o.w = pk2(s[6 * 33], s[7 * 33]);
            *(v4u*)(WT + (size_t)(n0 + n - nsub) * K + k0 + 8 * c) = o; } }
    LDS_WAIT(); asm volatile("" ::: "memory");
}
template <int R, bool FP8 = false, int SH = 0> __device__ __forceinline__ void rms_rows_to_bf16(int lane, const float* xrow, const float* g, bf16* orow, unsigned char* orow8 = nullptr) {
    const f32x4* gr = (const f32x4*)g + lane;
    f32x4 v[R][4]; float s[R];
#pragma unroll
    for (int r = 0; r < R; ++r) { const f32x4* xr = (const f32x4*)(xrow + (size_t)r * D) + lane;
#pragma unroll
        for (int j = 0; j < 4; ++j) v[r][j] = __builtin_nontemporal_load(xr + 64 * j); }
#pragma unroll
    for (int r = 0; r < R; ++r) { float a = 0.f;
#pragma unroll
        for (int j = 0; j < 4; ++j) a += (v[r][j].x * v[r][j].x + v[r][j].y * v[r][j].y) + (v[r][j].z * v[r][j].z + v[r][j].w * v[r][j].w);
        s[r] = a; }
#pragma unroll
    for (int o = 1; o < 64; o <<= 1) {
#pragma unroll
        for (int r = 0; r < R; ++r) s[r] += __shfl_xor(s[r], o); }
    f32x4 gg[4];
#pragma unroll
    for (int j = 0; j < 4; ++j) gg[j] = gr[64 * j];
#pragma unroll
    for (int r = 0; r < R; ++r) { const float rstd = 1.f / sqrtf(s[r] * (1.f / D) + RMS_EPS);
        if constexpr (FP8) { unsigned* o4 = (unsigned*)(orow8 + (size_t)r * D) + lane; constexpr float sc = (float)(1 << SH);
#pragma unroll
            for (int j = 0; j < 4; ++j) { int p = __builtin_amdgcn_cvt_pk_fp8_f32(v[r][j].x * rstd * gg[j].x * sc, v[r][j].y * rstd * gg[j].y * sc, 0, false); p = __builtin_amdgcn_cvt_pk_fp8_f32(v[r][j].z * rstd * gg[j].z * sc, v[r][j].w * rstd * gg[j].w * sc, p, true); o4[64 * j] = (unsigned)p; } }
        { v2u* o8 = (v2u*)(orow + (size_t)r * D) + lane;
#pragma unroll
            for (int j = 0; j < 4; ++j) { v2u o; o.x = pk2(v[r][j].x * rstd * gg[j].x, v[r][j].y * rstd * gg[j].y); o.y = pk2(v[r][j].z * rstd * gg[j].z, v[r][j].w * rstd * gg[j].w); o8[64 * j] = o; } } }
}
__device__ __forceinline__ void p0_fold_task(Frame& F, LAS float* scr, int task) {
    const int nq = task & 7, kg = (task >> 3) & 15, hp = task >> 7;
    const int k = kg * 64 + F.lane;
    f32x4 w[32];
#pragma unroll
    for (int qr = 0; qr < 4; ++qr) {
        const float* src = F.w_query + (size_t)(kg * 64 + (F.lane >> 3)) * (PH * PQ) + hp * 128 + qr * 32 + (F.lane & 7) * 4;
        f32x4 t[8];
#pragma unroll
        for (int i = 0; i < 8; ++i) t[i] = *(const f32x4*)(src + (size_t)i * 8 * (PH * PQ));
#pragma unroll
        for (int i = 0; i < 8; ++i) *(LAS f32x4*)(scr + (i * 8 + (F.lane >> 3)) * 36 + (F.lane & 7) * 4) = t[i];
        LDS_WAIT(); asm volatile("" ::: "memory");
#pragma unroll
        for (int i = 0; i < 8; ++i) w[qr * 8 + i] = *(const LAS f32x4*)(scr + F.lane * 36 + i * 4);
        LDS_WAIT(); asm volatile("" ::: "memory");
    }
    const float gk = F.rms_ffn_g[k];
    {
        const f32x4* skg = (const f32x4*)(F.sub_keys + ((size_t)hp * 128 + nq * 16) * 128) + F.lane;
        f32x4 t[8];
#pragma unroll
        for (int i = 0; i < 8; ++i) t[i] = skg[i * 64];
#pragma unroll
        for (int i = 0; i < 8; ++i) *(LAS f32x4*)(scr + (i * 64 + F.lane) * 4) = t[i];
        LDS_WAIT(); asm volatile("" ::: "memory");
    }
    for (int nn = 0; nn < 16; ++nn) { const int n = nq * 16 + nn;
        const LAS f32x4* sk = (const LAS f32x4*)(scr + nn * 128);
        float a0 = 0.f, a1 = 0.f, a2 = 0.f, a3 = 0.f;
#pragma unroll
        for (int i = 0; i < 32; ++i) { const f32x4 s = sk[i]; a0 += s.x * w[i].x; a1 += s.y * w[i].y; a2 += s.z * w[i].z; a3 += s.w * w[i].w; }
        F.WqT[(size_t)(hp * 128 + n) * D + k] = (bf16)f2bf(((a0 + a1) + (a2 + a3)) * gk);
    }
    LDS_WAIT(); asm volatile("" ::: "memory");
}
__device__ __forceinline__ void p0_prologue(Frame& F) {
    LAS float* scr = (LAS float*)(F.lds + RING_OFF + F.wave * 16384);
    const int gw = F.vcu * NWAVES + F.wave, NGW = F.G * NWAVES;
    if (!(F.wave & 1)) {
    for (int rep = 0; rep < 1 + ((DBG_P0REP >> 0) & 1); ++rep)
    for (int it = gw; it < 2048; it += NGW) p0_fold_task(F, scr, it);
    }
    constexpr int I_IN = (D / 64) * (NIN / 32), I_R = (RW / 64) * (D / 32), I_C = (CCH / 64) * (D / 32), I_O = (D / 64) * (D / 32);
    constexpr int NITEMS = I_IN + I_R + I_C + I_O;
    for (int rep = 0; rep < 1 + ((DBG_P0REP >> 1) & 1); ++rep)
    for (int it = gw; it < NITEMS; it += NGW) {
        int r = it;
        if (r < I_IN) {
            if (P1_FP8 && (r % (NIN / 32)) * 32 >= P1_NB) p0_transpose_item<true, P1_SB, GLU_P1>(F.w_in, D, NIN, (bf16*)F.WinT8, scr, r, F.lane, P1_NB); else p0_transpose_item(F.w_in, D, NIN, F.WinT, scr, r, F.lane);
            continue; } r -= I_IN;
        if (r < I_R) { p0_transpose_item(F.w_ret_proj, RW, D, F.WrT, scr, r, F.lane); continue; } r -= I_R;
        if (r < I_C) { p0_transpose_item(F.w_conv_proj, CCH, D, F.WcT, scr, r, F.lane); continue; } r -= I_C;
        p0_transpose_item<P6_FP8, P6_SB>(F.w_out, D, D, F.WoT, scr, r, F.lane);
    }
    for (int rep = 0; rep < 1 + ((DBG_P0REP >> 2) & 1); ++rep)
    for (int m = gw * 4; m < M; m += NGW * 4) rms_rows_to_bf16<4, P1_FP8, P1_SA>(F.lane, F.x + (size_t)m * D, F.rms_mix_g, F.XN + (size_t)m * D, F.XN8 + (size_t)m * D);
    for (int rep = 0; rep < 1 + ((DBG_P0REP >> 3) & 1); ++rep)
    for (int r0 = gw * 4; r0 < 2 * NEXP; r0 += NGW * 4) {
        const bool isv = r0 >= NEXP; const int row0 = isv ? r0 - NEXP : r0;
        const float* base = (isv ? F.peer_v : F.peer_u) + (size_t)row0 * D;
        f32x4 v[4][4]; float ss[4];
#pragma unroll
        for (int r = 0; r < 4; ++r) { const f32x4* src = (const f32x4*)(base + (size_t)r * D) + 2 * F.lane;
            v[r][0] = __builtin_nontemporal_load(src); v[r][1] = __builtin_nontemporal_load(src + 1); v[r][2] = __builtin_nontemporal_load(src + 128); v[r][3] = __builtin_nontemporal_load(src + 129); }
#pragma unroll
        for (int r = 0; r < 4; ++r) { float a = 0.f;
#pragma unroll
            for (int j = 0; j < 4; ++j) a += (v[r][j].x * v[r][j].x + v[r][j].y * v[r][j].y) + (v[r][j].z * v[r][j].z + v[r][j].w * v[r][j].w);
            ss[r] = a; }
#pragma unroll
        for (int o = 1; o < 64; o <<= 1) {
#pragma unroll
            for (int r = 0; r < 4; ++r) ss[r] += __shfl_xor(ss[r], o); }
#pragma unroll
        for (int r = 0; r < 4; ++r) {
            const float rms = ss[r] > 0.f ? sqrtf(ss[r] * (1.f / D)) : 1.0f;
            const float sc = 0.5f * rms, inv = 1.0f / sc;
            unsigned* dst = (unsigned*)(F.UT + (size_t)(row0 + r) * D + (isv ? D / 2 : 0)) + F.lane;
#pragma unroll
            for (int j = 0; j < 2; ++j) {
                const f32x4 a = v[r][2 * j], b = v[r][2 * j + 1];
                const float e[8] = {a.x, a.y, a.z, a.w, b.x, b.y, b.z, b.w}; unsigned w = 0u;
                w = __builtin_amdgcn_cvt_scalef32_pk_fp4_f32(w, e[0] * inv, e[1] * inv, 1.0f, 0);
                w = __builtin_amdgcn_cvt_scalef32_pk_fp4_f32(w, e[2] * inv, e[3] * inv, 1.0f, 1);
                w = __builtin_amdgcn_cvt_scalef32_pk_fp4_f32(w, e[4] * inv, e[5] * inv, 1.0f, 2);
                w = __builtin_amdgcn_cvt_scalef32_pk_fp4_f32(w, e[6] * inv, e[7] * inv, 1.0f, 3);
                __builtin_nontemporal_store(w, dst + 64 * j);
            }
            if (F.lane == 0) ((_Float16*)F.USC)[2 * (row0 + r) + (isv ? 1 : 0)] = (_Float16)sc;
        }
    }
    if (F.wave & 1) { for (int it = gw; it < 2048; it += NGW) p0_fold_task(F, scr, it); }
}

__device__ __forceinline__ float lg2_gamma(int h) { return h == 0 ? -0.04580368961312479f : h == 1 ? -0.02272007650008353f : h == 2 ? -0.011315313227834146f : -0.005646563141142062f; }
__device__ __forceinline__ bf16x8 lds_frag(const LAS bf16* p) { return *(const LAS bf16x8*)p; }
typedef short p2v4s __attribute__((ext_vector_type(4)));
__device__ __forceinline__ bf16x8 lds_frag_tr(const LAS bf16* img, int ld, int r0, int n0, int fr) {
    const LAS bf16* p = img + (r0 + (fr >> 2)) * ld + n0 + 4 * (fr & 3);
    const p2v4s a = __builtin_amdgcn_ds_read_tr16_b64_v4i16((LAS p2v4s*)p), b = __builtin_amdgcn_ds_read_tr16_b64_v4i16((LAS p2v4s*)(p + 4 * ld));
    return __builtin_shufflevector(a, b, 0, 1, 2, 3, 4, 5, 6, 7);
}
#define MFMA16(a, b, c) __builtin_amdgcn_mfma_f32_16x16x32_bf16((a), (b), (c), 0, 0, 0)

__device__ __forceinline__ void rope8(const v4u a, const v4u b, const f32x4* rp4, float sc, float (&o1)[8], float (&o2)[8]) {
    const unsigned aw[4] = {a.x, a.y, a.z, a.w}, bw[4] = {b.x, b.y, b.z, b.w};
#pragma unroll
    for (int j = 0; j < 4; ++j) {
        const f32x4 cs = rp4[j];
        const float t1a = bflo(aw[j]), t1b = bfhi(aw[j]), t2a = bflo(bw[j]), t2b = bfhi(bw[j]);
        o1[2 * j] = (t1a * cs.x - t2a * cs.y) * sc; o2[2 * j] = (t1a * cs.y + t2a * cs.x) * sc;
        o1[2 * j + 1] = (t1b * cs.z - t2b * cs.w) * sc; o2[2 * j + 1] = (t1b * cs.w + t2b * cs.z) * sc;
    }
}

__device__ __forceinline__ void rope_cs(int pos, int q, float (&cs)[8], float (&sn)[8]) {
#pragma unroll
    for (int j = 0; j < 8; ++j) {
        const float f = __builtin_amdgcn_exp2f((float)(8 * q + j) * -0.41524101186092029f) * 0.15915494309189535f;
        const float rev = __builtin_amdgcn_fractf((float)pos * f);
        cs[j] = __builtin_amdgcn_cosf(rev); sn[j] = __builtin_amdgcn_sinf(rev);
    }
}
__device__ __forceinline__ void rope8f(const v4u a, const v4u b, const float (&cs)[8], const float (&sn)[8], float sc, float (&o1)[8], float (&o2)[8]) {
    const unsigned aw[4] = {a.x, a.y, a.z, a.w}, bw[4] = {b.x, b.y, b.z, b.w};
#pragma unroll
    for (int j = 0; j < 8; ++j) {
        const float t1 = (j & 1) ? bfhi(aw[j >> 1]) : bflo(aw[j >> 1]), t2 = (j & 1) ? bfhi(bw[j >> 1]) : bflo(bw[j >> 1]);
        o1[j] = (t1 * cs[j] - t2 * sn[j]) * sc; o2[j] = (t1 * sn[j] + t2 * cs[j]) * sc;
    }
}

constexpr int KT_LD = 136, P2_KLD = 72, P2_KT = 0, P2_VT = 128 * P2_KLD * 2;
struct P2Regs { v4u ka, kb; f32x4 rp[4]; v4u vv[4]; };
__device__ __forceinline__ void p2_state_load(Frame& F, int item, P2Regs& R) {
    const int h = item & 3, c = (item >> 2) & 31, b = item >> 7, t0 = b * SEQ + c * RC, m = F.tid >> 2, q = F.tid & 3;
    const bf16* krow = F.KH + ((size_t)item * 128 + m) * RDK;
    R.ka = __builtin_nontemporal_load((const v4u*)(krow + q * 8)); R.kb = __builtin_nontemporal_load((const v4u*)(krow + 32 + q * 8));
    const bf16* vp = F.VH + ((size_t)item * 128 + (F.tid >> 4)) * RDV + (F.tid & 15) * 8;
#pragma unroll
    for (int i = 0; i < 4; ++i) R.vv[i] = __builtin_nontemporal_load((const v4u*)(vp + (size_t)i * 32 * RDV));
}
__device__ __forceinline__ void p2_state_stage(Frame& F, int item, const P2Regs& R) {
    const int h = item & 3, m = F.tid >> 2, q = F.tid & 3;
    LAS bf16* KT = (LAS bf16*)(F.lds + P2_KT); LAS bf16* VT = (LAS bf16*)(F.lds + P2_VT);
    float o1[8], o2[8];
    { float cs[8], sn[8]; rope_cs(((item >> 2) & 31) * RC + m, q, cs, sn);
      rope8f(R.ka, R.kb, cs, sn, 0.125f * __builtin_amdgcn_exp2f(lg2_gamma(h) * (float)(127 - m)), o1, o2); }
    { v4u w1, w2; w1.x = pk2(o1[0], o1[1]); w1.y = pk2(o1[2], o1[3]); w1.z = pk2(o1[4], o1[5]); w1.w = pk2(o1[6], o1[7]);
      w2.x = pk2(o2[0], o2[1]); w2.y = pk2(o2[2], o2[3]); w2.z = pk2(o2[4], o2[5]); w2.w = pk2(o2[6], o2[7]);
      *(LAS v4u*)(KT + m * P2_KLD + q * 8) = w1; *(LAS v4u*)(KT + m * P2_KLD + 32 + q * 8) = w2; }
#pragma unroll
    for (int i = 0; i < 4; ++i) *(LAS v4u*)(VT + ((F.tid >> 4) + 32 * i) * KT_LD + (F.tid & 15) * 8) = R.vv[i];
}
__device__ __forceinline__ void p2_state_compute(Frame& F, int item) {
    LAS bf16* KT = (LAS bf16*)(F.lds + P2_KT); LAS bf16* VT = (LAS bf16*)(F.lds + P2_VT);
    {
        const int w = F.wave, fr = F.lane & 15, fq = F.lane >> 4;
        f32x4 acc[4];
#pragma unroll
        for (int i = 0; i < 4; ++i) acc[i] = (f32x4){0.f, 0.f, 0.f, 0.f};
#pragma unroll
        for (int kk = 0; kk < 4; ++kk) {
            const bf16x8 bfrag = lds_frag_tr(VT, KT_LD, kk * 32 + fq * 8, w * 16, fr);
#pragma unroll
            for (int dkt = 0; dkt < 4; ++dkt) { const bf16x8 afrag = lds_frag_tr(KT, P2_KLD, kk * 32 + fq * 8, dkt * 16, fr); acc[dkt] = MFMA16(afrag, bfrag, acc[dkt]); }
        }
        bf16* sp = F.S + (size_t)item * (RDV * RDK) + (size_t)(w * 16 + fr) * RDK + fq * 4;
#pragma unroll
        for (int dkt = 0; dkt < 4; ++dkt) { v2u o; o.x = pk2(acc[dkt][0], acc[dkt][1]); o.y = pk2(acc[dkt][2], acc[dkt][3]); *(v2u*)(sp + dkt * 16) = o; }
    }
}

constexpr int CV_TOK = 64, CV_ROWS = CV_TOK + CK - 1, P2_CT = 0, P2_YT = CV_ROWS * CCH * 2;
static_assert(P2_YT + 16 * CCH * 4 <= RING_BYTES, "conv LDS");
typedef __fp16 cvh2 __attribute__((ext_vector_type(2)));
constexpr int CV_NIT = (CV_ROWS * (CCH / 8) + NWAVES * 64 - 1) / (NWAVES * 64);
struct CvRegs { v4u uv[CV_NIT]; };
__device__ __forceinline__ void p2_conv_load(Frame& F, int ct, CvRegs& R) {
    const int t0 = ct * CV_TOK, s0 = t0 % SEQ;
#pragma unroll
    for (int i = 0; i < CV_NIT; ++i) {
        const int e = F.tid + i * NWAVES * 64, r = e >> 6, cg = e & 63;
        R.uv[i] = (v4u){0u, 0u, 0u, 0u};
        if (e < CV_ROWS * (CCH / 8) && s0 + r - (CK - 1) >= 0) R.uv[i] = __builtin_nontemporal_load((const v4u*)(F.PROJ + (size_t)(t0 + r - (CK - 1)) * CCH + cg * 8));
    }
}
__device__ __forceinline__ void p2_conv_stage(Frame& F, const CvRegs& R) {
    LAS bf16* CT = (LAS bf16*)(F.lds + P2_CT);
#pragma unroll
    for (int i = 0; i < CV_NIT; ++i) {
        const int e = F.tid + i * NWAVES * 64, r = e >> 6, cg = e & 63;
        if (e < CV_ROWS * (CCH / 8)) *(LAS v4u*)(CT + r * CCH + cg * 8) = R.uv[i];
    }
}
__device__ __forceinline__ void p2_conv_compute(Frame& F, int ct, int ctn, CvRegs& R) {
    const int t0 = ct * CV_TOK;
    LAS bf16* CT = (LAS bf16*)(F.lds + P2_CT); LAS float* YT = (LAS float*)(F.lds + P2_YT);
    const int ch = F.tid;
    float wt[CK];
#pragma unroll
    for (int j = 0; j < CK; ++j) wt[j] = F.conv_dw_w[j * CCH + ch];
    const float bias = F.conv_dw_b[ch];
    cvh2 tp[16];
#pragma unroll
    for (int k = 0; k < 16; ++k) tp[k] = __builtin_amdgcn_cvt_pkrtz(wt[2 * k], 2 * k + 1 < CK ? wt[2 * k + 1] : 0.f);
    const f32x4 g0 = *(const f32x4*)(F.conv_ln_g + F.lane * 8), g1 = *(const f32x4*)(F.conv_ln_g + F.lane * 8 + 4);
    const f32x4 e0 = *(const f32x4*)(F.conv_ln_b + F.lane * 8), e1 = *(const f32x4*)(F.conv_ln_b + F.lane * 8 + 4);
    LDS_BARRIER();
    if (ctn >= 0) p2_conv_load(F, ctn, R);
    for (int st = 0; st < CV_TOK / 16; ++st) {
        cvh2 E[23], O[23];
        { float wp = bf1(CT[(st * 16) * CCH + ch]);
#pragma unroll
          for (int k = 0; k < 23; ++k) { const float w1 = bf1(CT[(st * 16 + 2 * k + 1) * CCH + ch]), w2 = (2 * k + 2 < 16 + CK - 1) ? bf1(CT[(st * 16 + 2 * k + 2) * CCH + ch]) : 0.f;
              E[k] = __builtin_amdgcn_cvt_pkrtz(wp, w1); O[k] = __builtin_amdgcn_cvt_pkrtz(w1, w2); wp = w2; } }
#pragma unroll
        for (int i = 0; i < 16; ++i) { float y = bias;
#pragma unroll
            for (int k = 0; k < 16; ++k) y = __builtin_amdgcn_fdot2((i & 1) ? O[(i >> 1) + k] : E[(i >> 1) + k], tp[k], y, false);
            YT[i * CCH + ch] = y; }
        LDS_BARRIER();
#pragma unroll
        for (int rr = 0; rr < 2; ++rr) {
            const int i = F.wave + rr * 8;
            const f32x4 a = *(const LAS f32x4*)(YT + i * CCH + F.lane * 8), b2 = *(const LAS f32x4*)(YT + i * CCH + F.lane * 8 + 4);
            const float mean = wave_sum_dpp((a.x + a.y) + (a.z + a.w) + (b2.x + b2.y) + (b2.z + b2.w)) * (1.f / CCH);
            const f32x4 da = a - mean, db = b2 - mean;
            const float var = wave_sum_dpp((da.x * da.x + da.y * da.y) + (da.z * da.z + da.w * da.w) + (db.x * db.x + db.y * db.y) + (db.z * db.z + db.w * db.w)) * (1.f / CCH);
            const float rstd = 1.f / sqrtf(var + LN_EPS);
            f32x4 y0 = da * rstd * g0 + e0, y1 = db * rstd * g1 + e1;
            y0.x *= sigm(y0.x); y0.y *= sigm(y0.y); y0.z *= sigm(y0.z); y0.w *= sigm(y0.w);
            y1.x *= sigm(y1.x); y1.y *= sigm(y1.y); y1.z *= sigm(y1.z); y1.w *= sigm(y1.w);
            v4u o; o.x = pk2(y0.x, y0.y); o.y = pk2(y0.z, y0.w); o.z = pk2(y1.x, y1.y); o.w = pk2(y1.z, y1.w);
            *(v4u*)(F.CB + (size_t)(t0 + st * 16 + i) * CCH + F.lane * 8) = o;
        }
        LDS_BARRIER();
    }
}

__device__ __forceinline__ void p3_scan(Frame& F) {
    const int NT = F.G * NWAVES * 64, gt = F.vcu * (NWAVES * 64) + F.tid;
    constexpr int PER = RDV * RDK / 2;
    for (int e = gt; e < BATCH * RH * PER; e += NT) {
        const int p = e % PER, h = (e / PER) & 3, b = e / (PER * RH);
        const float dec = __builtin_amdgcn_exp2f(lg2_gamma(h) * 128.0f);
        unsigned* sp = (unsigned*)F.S + ((size_t)(b * NCH) * RH + h) * PER + p;
        unsigned v[NCH];
#pragma unroll
        for (int c = 0; c < NCH; ++c) v[c] = __builtin_nontemporal_load(sp + (size_t)c * RH * PER);
        float s0 = 0.f, s1 = 0.f;
#pragma unroll
        for (int c = 0; c < NCH; ++c) { sp[(size_t)c * RH * PER] = pk2(s0, s1); s0 = s0 * dec + bflo(v[c]); s1 = s1 * dec + bfhi(v[c]); }
    }
}

constexpr int QK_LD = 72, P4_QS = 0, P4_KS = P4_QS + 128 * QK_LD * 2, P4_VT = P4_KS + 128 * QK_LD * 2, P4_ST = P4_VT + 128 * KT_LD * 2, P4_PS = P4_ST + 128 * QK_LD * 2, P4_END = P4_PS + 128 * KT_LD * 2;
static_assert(P4_END <= RING_BYTES, "P4 LDS");
struct P4Regs { v4u qa, qb, ka, kb; f32x4 rp[4]; v4u vv[4]; v4u st[2]; v4u g[4]; };
__device__ __forceinline__ void p4_load(Frame& F, int item, P4Regs& R) {
    const int h = item & 3, c = (item >> 2) & 31, b = item >> 7, t0 = b * SEQ + c * RC, m = F.tid >> 2, q = F.tid & 3;
    const bf16* qrow = F.QH + ((size_t)item * 128 + m) * RDK; const bf16* krow = F.KH + ((size_t)item * 128 + m) * RDK;
    R.qa = __builtin_nontemporal_load((const v4u*)(qrow + q * 8)); R.qb = __builtin_nontemporal_load((const v4u*)(qrow + 32 + q * 8));
    R.ka = __builtin_nontemporal_load((const v4u*)(krow + q * 8)); R.kb = __builtin_nontemporal_load((const v4u*)(krow + 32 + q * 8));
    const bf16* vp = F.VH + ((size_t)item * 128 + (F.tid >> 4)) * RDV + (F.tid & 15) * 8;
#pragma unroll
    for (int i = 0; i < 4; ++i) R.vv[i] = __builtin_nontemporal_load((const v4u*)(vp + (size_t)i * 32 * RDV));
    const bf16* sp = F.S + (size_t)item * (RDV * RDK);
#pragma unroll
    for (int i = 0; i < 2; ++i) { const int pc = F.tid + i * 512, dv = pc >> 3, d8 = pc & 7; R.st[i] = __builtin_nontemporal_load((const v4u*)(sp + dv * RDK + d8 * 8)); }
    { const int n = F.wave * 16 + (F.lane >> 2), d0 = (F.lane & 3) * 32; const bf16* grow = F.GH + ((size_t)item * 128 + n) * RDV + d0;
#pragma unroll
      for (int i = 0; i < 4; ++i) R.g[i] = __builtin_nontemporal_load((const v4u*)(grow + i * 8)); }
}
__device__ __forceinline__ void p4_stage(Frame& F, int item, const P4Regs& R) {
    const int h = item & 3;
    LAS bf16* QS = (LAS bf16*)(F.lds + P4_QS); LAS bf16* KS = (LAS bf16*)(F.lds + P4_KS); LAS bf16* VT = (LAS bf16*)(F.lds + P4_VT); LAS bf16* ST = (LAS bf16*)(F.lds + P4_ST);
    const float lg = lg2_gamma(h);
    const int m = F.tid >> 2, q = F.tid & 3;
    float o1[8], o2[8], cs[8], sn[8]; rope_cs(((item >> 2) & 31) * RC + m, q, cs, sn);
    {
        rope8f(R.qa, R.qb, cs, sn, __builtin_amdgcn_exp2f(lg * (float)(m + 1)), o1, o2);
        v4u w1, w2; w1.x = pk2(o1[0], o1[1]); w1.y = pk2(o1[2], o1[3]); w1.z = pk2(o1[4], o1[5]); w1.w = pk2(o1[6], o1[7]);
        w2.x = pk2(o2[0], o2[1]); w2.y = pk2(o2[2], o2[3]); w2.z = pk2(o2[4], o2[5]); w2.w = pk2(o2[6], o2[7]);
        *(LAS v4u*)(QS + m * QK_LD + q * 8) = w1; *(LAS v4u*)(QS + m * QK_LD + 32 + q * 8) = w2;
    }
    {
        rope8f(R.ka, R.kb, cs, sn, 0.125f * __builtin_amdgcn_exp2f(-lg * (float)(m + 1)), o1, o2);
        v4u w1, w2; w1.x = pk2(o1[0], o1[1]); w1.y = pk2(o1[2], o1[3]); w1.z = pk2(o1[4], o1[5]); w1.w = pk2(o1[6], o1[7]);
        w2.x = pk2(o2[0], o2[1]); w2.y = pk2(o2[2], o2[3]); w2.z = pk2(o2[4], o2[5]); w2.w = pk2(o2[6], o2[7]);
        *(LAS v4u*)(KS + m * QK_LD + q * 8) = w1; *(LAS v4u*)(KS + m * QK_LD + 32 + q * 8) = w2;
    }
#pragma unroll
    for (int i = 0; i < 4; ++i) *(LAS v4u*)(VT + ((F.tid >> 4) + 32 * i) * KT_LD + (F.tid & 15) * 8) = R.vv[i];
#pragma unroll
    for (int i = 0; i < 2; ++i) { const int pc = F.tid + i * 512, dv = pc >> 3, d8 = pc & 7; *(LAS v4u*)(ST + dv * QK_LD + d8 * 8) = R.st[i]; }
}
__device__ __forceinline__ void p4_compute(Frame& F, int item, const v4u (&gpre)[4]) {
    const int h = item & 3, c = (item >> 2) & 31, b = item >> 7;
    const int t0 = b * SEQ + c * RC;
    LAS bf16* QS = (LAS bf16*)(F.lds + P4_QS); LAS bf16* KS = (LAS bf16*)(F.lds + P4_KS); LAS bf16* VT = (LAS bf16*)(F.lds + P4_VT);
    LAS bf16* ST = (LAS bf16*)(F.lds + P4_ST); LAS bf16* PS = (LAS bf16*)(F.lds + P4_PS);
    const int w = F.wave, fr = F.lane & 15, fq = F.lane >> 4;
    const int nkk = (w >> 1) + 1;
    {
        const bf16x8 qa0 = lds_frag(QS + (w * 16 + fr) * QK_LD + fq * 8), qa1 = lds_frag(QS + (w * 16 + fr) * QK_LD + 32 + fq * 8);
        for (int jt = 0; jt < 2 * nkk; ++jt) {
            f32x4 s = (f32x4){0.f, 0.f, 0.f, 0.f};
            if (jt <= w) {
                const bf16x8 kb0 = lds_frag(KS + (jt * 16 + fr) * QK_LD + fq * 8), kb1 = lds_frag(KS + (jt * 16 + fr) * QK_LD + 32 + fq * 8);
                s = MFMA16(qa0, kb0, s); s = MFMA16(qa1, kb1, s);
            }
            const int mcol = jt * 16 + fr;
#pragma unroll
            for (int r = 0; r < 4; ++r) { const int n = w * 16 + fq * 4 + r; PS[n * KT_LD + mcol] = (bf16)f2bf(n >= mcol ? s[r] : 0.f); }
        }
    }
    LDS_BARRIER();
    f32x4 o[8];
    {
        const bf16x8 qa0 = lds_frag(QS + (w * 16 + fr) * QK_LD + fq * 8), qa1 = lds_frag(QS + (w * 16 + fr) * QK_LD + 32 + fq * 8);
#pragma unroll
        for (int jt = 0; jt < 8; ++jt) {
            f32x4 a = (f32x4){0.f, 0.f, 0.f, 0.f};
            a = MFMA16(qa0, lds_frag(ST + (jt * 16 + fr) * QK_LD + fq * 8), a);
            a = MFMA16(qa1, lds_frag(ST + (jt * 16 + fr) * QK_LD + 32 + fq * 8), a);
            for (int kk = 0; kk < nkk; ++kk) a = MFMA16(lds_frag(PS + (w * 16 + fr) * KT_LD + kk * 32 + fq * 8), lds_frag_tr(VT, KT_LD, kk * 32 + fq * 8, jt * 16, fr), a);
            o[jt] = a;
        }
    }
    float mean[4], rstd[4];
#pragma unroll
    for (int r = 0; r < 4; ++r) {
        float s = 0.f;
#pragma unroll
        for (int jt = 0; jt < 8; ++jt) s += o[jt][r];
        s = row16_sum(s);
        mean[r] = s * (1.f / RDV);
        float q2 = 0.f;
#pragma unroll
        for (int jt = 0; jt < 8; ++jt) { const float d = o[jt][r] - mean[r]; q2 += d * d; }
        q2 = row16_sum(q2);
        rstd[r] = 1.f / sqrtf(q2 * (1.f / RDV) + LN_EPS);
    }
    LDS_BARRIER();
#pragma unroll
    for (int jt = 0; jt < 8; ++jt) { const float gg = F.ret_gn_g[h * RDV + jt * 16 + fr];
#pragma unroll
        for (int r = 0; r < 4; ++r) PS[(w * 16 + fq * 4 + r) * KT_LD + jt * 16 + fr] = (bf16)f2bf((o[jt][r] - mean[r]) * rstd[r] * gg); }
    LDS_BARRIER();
    {
        const int n = w * 16 + (F.lane >> 2), d0 = (F.lane & 3) * 32;
        bf16* orow = F.RA + (size_t)(t0 + n) * RW + h * RDV + d0;
#pragma unroll
        for (int i = 0; i < 4; ++i) {
            const v4u y = *(const LAS v4u*)(PS + n * KT_LD + d0 + i * 8); const v4u g = gpre[i];
            const unsigned yw[4] = {y.x, y.y, y.z, y.w}, gw[4] = {g.x, g.y, g.z, g.w}; unsigned ow[4];
#pragma unroll
            for (int j = 0; j < 4; ++j) { const float ga = bflo(gw[j]), gb = bfhi(gw[j]); ow[j] = pk2(bflo(yw[j]) * ga * sigm(ga), bfhi(yw[j]) * gb * sigm(gb)); }
            *(v4u*)(orow + i * 8) = (v4u){ow[0], ow[1], ow[2], ow[3]};
        }
    }
    LDS_BARRIER();
}

#if DBG_PROBE
__device__ __forceinline__ void dbg_probe(Frame& F, int stage) {
    const int gw = F.vcu * NWAVES + F.wave, NGW = F.G * NWAVES;
    for (int m = gw; m < M; m += NGW) {
        const size_t t = (size_t)m; const int lane = F.lane; bool bad = false;
        const int cls = (int)(t & 7);
        const void* prow = nullptr; int nvec = 0; int mode = 0;
        if (cls == 1) { prow = F.ROPE + (t % SEQ) * 32; nvec = 16; mode = 1; }
        else if (cls == 2 || cls == 3) { prow = F.S + (t >> 5) * 8192; nvec = 1024; }
        else if (cls >= 4) { prow = F.PROJ + t * NIN; nvec = 1536 / 8; mode = 2; }
        for (int i = lane; i < nvec; i += 64) { const v4u w = ((const v4u*)prow)[i]; const unsigned ww[4] = {w.x, w.y, w.z, w.w};
#pragma unroll
            for (int j = 0; j < 4; ++j) {
                if (mode == 0) bad |= ((ww[j] & 0x7f80u) == 0x7f80u) | ((ww[j] & 0x7f800000u) == 0x7f800000u);
                else if (mode == 1) bad |= ((ww[j] & 0x7f800000u) == 0x7f800000u);
                else bad |= ((ww[j] & 0x7f80u) >= (133u << 7)) | ((ww[j] & 0x7f800000u) >= (133u << 23)); } }
        bad = __any(bad);
        if (lane == 0) ((unsigned*)((unsigned char*)F.UT - 1 * MiB))[t] = bad ? 1u : 0u;
    }
}
#endif
constexpr int P9_VR = DBG_P9_VR;
constexpr int P9_TOK = 64, P9_IDX = 0, P9_CQ = P9_IDX + 128 * 128 * 2, P9_CINV = P9_CQ + 128 * 128, P9_GU = P9_CINV + 512, P9_LUT = P9_GU + P9_TOK * 128 * 4, P9_ZP = P9_LUT  , P9_HROW = P9_ZP + P9_TOK * 128 * 4, P9_IMG = P9_GU, P9_IMG_BLK = 520, P9_IMG_W = 16 * P9_IMG_BLK,
              P9_GV = (P9_IMG + NWAVES * P9_IMG_W > P9_HROW + NWAVES * 512 ? P9_IMG + NWAVES * P9_IMG_W : P9_HROW + NWAVES * 512), P9_ZERO = P9_GV + 2 * D * 4, P9_END = P9_ZERO + 512;
static_assert(P9_END <= RING_BYTES && P9_LUT + 512 * 32 <= P9_HROW, "P9 LDS");
__device__ __forceinline__ unsigned mono16(unsigned hb) { return (hb & 0x8000u) ? (~hb & 0xffffu) : (hb | 0x8000u); }
__device__ __forceinline__ float unmono16(unsigned m) { const unsigned hb = (m & 0x8000u) ? (m & 0x7fffu) : (~m & 0xffffu); return (float)__builtin_bit_cast(_Float16, (unsigned short)hb); }
#define CE(a, b) do { const unsigned _h = (a) > (b) ? (a) : (b), _l = (a) > (b) ? (b) : (a); (a) = _h; (b) = _l; } while (0)
__device__ __forceinline__ void sort16_desc(unsigned (&K)[16]) {
    CE(K[0], K[1]); CE(K[2], K[3]); CE(K[0], K[2]); CE(K[1], K[3]); CE(K[1], K[2]); CE(K[4], K[5]);
    CE(K[6], K[7]); CE(K[4], K[6]); CE(K[5], K[7]); CE(K[5], K[6]); CE(K[0], K[4]); CE(K[2], K[6]);
    CE(K[2], K[4]); CE(K[1], K[5]); CE(K[3], K[7]); CE(K[3], K[5]); CE(K[1], K[2]); CE(K[3], K[4]);
    CE(K[5], K[6]); CE(K[8], K[9]); CE(K[10], K[11]); CE(K[8], K[10]); CE(K[9], K[11]); CE(K[9], K[10]);
    CE(K[12], K[13]); CE(K[14], K[15]); CE(K[12], K[14]); CE(K[13], K[15]); CE(K[13], K[14]); CE(K[8], K[12]);
    CE(K[10], K[14]); CE(K[10], K[12]); CE(K[9], K[13]); CE(K[11], K[15]); CE(K[11], K[13]); CE(K[9], K[10]);
    CE(K[11], K[12]); CE(K[13], K[14]); CE(K[0], K[8]); CE(K[4], K[12]); CE(K[4], K[8]); CE(K[2], K[10]);
    CE(K[6], K[14]); CE(K[6], K[10]); CE(K[2], K[4]); CE(K[6], K[8]); CE(K[10], K[12]); CE(K[1], K[9]);
    CE(K[5], K[13]); CE(K[5], K[9]); CE(K[3], K[11]); CE(K[7], K[15]); CE(K[7], K[11]); CE(K[3], K[5]);
    CE(K[7], K[9]); CE(K[11], K[13]); CE(K[1], K[2]); CE(K[3], K[4]); CE(K[5], K[6]); CE(K[7], K[8]);
    CE(K[9], K[10]); CE(K[11], K[12]); CE(K[13], K[14]);
}
__device__ __forceinline__ void merge16_desc(unsigned (&T)[16], const unsigned (&S)[16]) {
#pragma unroll
    for (int i = 0; i < 16; ++i) T[i] = T[i] > S[15 - i] ? T[i] : S[15 - i];
    CE(T[0], T[8]); CE(T[1], T[9]); CE(T[2], T[10]); CE(T[3], T[11]); CE(T[4], T[12]); CE(T[5], T[13]); CE(T[6], T[14]); CE(T[7], T[15]);
    CE(T[0], T[4]); CE(T[1], T[5]); CE(T[2], T[6]); CE(T[3], T[7]); CE(T[8], T[12]); CE(T[9], T[13]); CE(T[10], T[14]); CE(T[11], T[15]);
    CE(T[0], T[2]); CE(T[1], T[3]); CE(T[4], T[6]); CE(T[5], T[7]); CE(T[8], T[10]); CE(T[9], T[11]); CE(T[12], T[14]); CE(T[13], T[15]);
    CE(T[0], T[1]); CE(T[2], T[3]); CE(T[4], T[5]); CE(T[6], T[7]); CE(T[8], T[9]); CE(T[10], T[11]); CE(T[12], T[13]); CE(T[14], T[15]);
}
#undef CE
__device__ __forceinline__ void topk_list(const unsigned short* s, unsigned (&L)[16]) {
    v4u w0 = __builtin_nontemporal_load((const v4u*)(s)), w1 = __builtin_nontemporal_load((const v4u*)(s + 8));
    {
        const unsigned ww[8] = {w0.x, w0.y, w0.z, w0.w, w1.x, w1.y, w1.z, w1.w};
        w0 = __builtin_nontemporal_load((const v4u*)(s + 128)); w1 = __builtin_nontemporal_load((const v4u*)(s + 128 + 8));
#pragma unroll
        for (int e = 0; e < 16; ++e) { L[e] = ((e & 1) ? (ww[e >> 1] & 0xffff0000u) : (ww[e >> 1] << 16)) | (unsigned)(127 - e);        }
        sort16_desc(L);
    }
#pragma unroll 1
    for (int c = 1; c < 8; ++c) {
        const unsigned ww[8] = {w0.x, w0.y, w0.z, w0.w, w1.x, w1.y, w1.z, w1.w};
        if (c < 7) { w0 = __builtin_nontemporal_load((const v4u*)(s + (c + 1) * 128)); w1 = __builtin_nontemporal_load((const v4u*)(s + (c + 1) * 128 + 8)); }
        unsigned S[16];
#pragma unroll
        for (int e = 0; e < 16; ++e) { S[e] = ((e & 1) ? (ww[e >> 1] & 0xffff0000u) : (ww[e >> 1] << 16)) | (unsigned)(127 - (c * 16 + e)); }
        sort16_desc(S); merge16_desc(L, S);
    }
}
__device__ __forceinline__ unsigned msum(float f) { const unsigned u = __builtin_bit_cast(unsigned, f); return (u & 0x80000000u) ? ~u : (u | 0x80000000u); }
__device__ __forceinline__ float gelu_erf(float v) {
    const float av = __builtin_fabsf(v), t = __builtin_amdgcn_rcpf(av * 0.2316418882f + 1.0f);
    float q = t * 0.5307027145f + (-0.7265760135f); q = q * t + 0.7107068705f; q = q * t + (-0.142248368f); q = q * t + 0.127414796f; q = q * t;
    const float e = __builtin_amdgcn_exp2f((v * v) * (-0.72134752044f));
    const float m = v * (q * e);
    return v < 0.f ? m : v - m;
}
__device__ __forceinline__ void p9_topk(Frame& F, const size_t t0, const int lt0) {
    LAS unsigned short* IDXS = (LAS unsigned short*)(F.lds + P9_IDX) + lt0 * 128; LAS unsigned* GU = (LAS unsigned*)(F.lds + P9_GU); LAS _Float16* GUH = (LAS _Float16*)GU;
    {
        int tidv = F.tid; asm volatile("" : "+v"(tidv));
        const int tl = tidv >> 3, hd = tidv & 7;
        const unsigned short* srow = F.SC + ((((size_t)hd * (M / 8) + ((t0 + tl) >> 3)) * 2) * 8) * 128 + (tl & 7) * 16;
        unsigned L1[16], L2[16];
        topk_list(srow, L1); topk_list(srow + 1024, L2);
        LAS unsigned* lut = (LAS unsigned*)(F.lds + P9_LUT) + tidv * 8;
        float v1[16], v2[16];
#pragma unroll
        for (int i = 0; i < 16; ++i) { v1[i] = unmono16(L1[i] >> 16); v2[i] = unmono16(L2[i] >> 16); }
#pragma unroll
        for (int i = 0; i < 4; ++i) {
            lut[i] = (127u - (L1[4 * i] & 0xffu)) | ((127u - (L1[4 * i + 1] & 0xffu)) << 8) | ((127u - (L1[4 * i + 2] & 0xffu)) << 16) | ((127u - (L1[4 * i + 3] & 0xffu)) << 24);
            lut[4 + i] = (127u - (L2[4 * i] & 0xffu)) | ((127u - (L2[4 * i + 1] & 0xffu)) << 8) | ((127u - (L2[4 * i + 2] & 0xffu)) << 16) | ((127u - (L2[4 * i + 3] & 0xffu)) << 24);
        }
        unsigned R[16];
#define CAND(i, j) ((msum(v1[i] + v2[j]) & 0xffffff00u) | (unsigned)(255 - ((i) * 16 + (j))))
        { const unsigned S[16] = {CAND(0, 0), CAND(0, 1), CAND(0, 2), CAND(0, 3), CAND(0, 4), CAND(0, 5), CAND(0, 6), CAND(0, 7), CAND(0, 8), CAND(0, 9), CAND(0, 10), CAND(0, 11), CAND(0, 12), CAND(0, 13), CAND(0, 14), CAND(0, 15)};
#pragma unroll
          for (int j = 0; j < 16; ++j) R[j] = S[j]; }
        { unsigned S[16] = {CAND(1, 0), CAND(1, 1), CAND(1, 2), CAND(1, 3), CAND(1, 4), CAND(1, 5), CAND(1, 6), CAND(1, 7), CAND(2, 0), CAND(2, 1), CAND(2, 2), CAND(2, 3), CAND(2, 4), CAND(3, 0), CAND(3, 1), CAND(3, 2)}; sort16_desc(S); merge16_desc(R, S); }
        { unsigned S[16] = {CAND(3, 3), CAND(4, 0), CAND(4, 1), CAND(4, 2), CAND(5, 0), CAND(5, 1), CAND(6, 0), CAND(6, 1), CAND(7, 0), CAND(7, 1), CAND(8, 0), CAND(9, 0), CAND(10, 0), CAND(11, 0), CAND(12, 0), CAND(13, 0)}; sort16_desc(S); merge16_desc(R, S); }
        { unsigned S[16] = {CAND(14, 0), CAND(15, 0), 0u, 0u, 0u, 0u, 0u, 0u, 0u, 0u, 0u, 0u, 0u, 0u, 0u, 0u}; sort16_desc(S); merge16_desc(R, S); }
#undef CAND
        const LAS unsigned char* lb = (const LAS unsigned char*)lut;
        float wv[16], vs[16], wsum = 0.f, vmax = 0.f;
#pragma unroll
        for (int r = 0; r < 16; ++r) {
            const unsigned key = R[r], mk = key & 0xffffff00u;
            const float val = __builtin_bit_cast(float, (mk & 0x80000000u) ? (mk & 0x7fffffffu) : ~mk);
            if (r == 0) vmax = val;
            wv[r] = __builtin_amdgcn_exp2f((val - vmax) * 1.4426950408889634f); wsum += wv[r];
            const unsigned pos = 255u - (key & 0xffu);
            const unsigned e1 = lb[pos >> 4], e2 = lb[16 + (pos & 15u)], ex = e1 * 128u + e2;
            IDXS[tl * 128 + hd * 16 + r] = (unsigned short)ex;
            const unsigned uv = ((const unsigned*)F.USC)[ex];
            ((LAS unsigned short*)GUH)[2 * (tl * 128 + hd * 16 + r)] = (unsigned short)(uv & 0xffffu); vs[r] = (float)__builtin_bit_cast(_Float16, (unsigned short)(uv >> 16));
        }
        const float inv = 1.0f / wsum;
#pragma unroll
        for (int r = 0; r < 16; ++r) GUH[2 * (tl * 128 + hd * 16 + r) + 1] = (_Float16)(wv[r] * inv * vs[r]);
    }
}
#define P9_EM (DBG_DUMMY_EMASK != 0 ? emask : 0xffff)
typedef int p9v8i __attribute__((ext_vector_type(8)));
typedef int p9v4i __attribute__((ext_vector_type(4)));
typedef int p9v2i __attribute__((ext_vector_type(2)));
__device__ __forceinline__ void p9_dots8(Frame& F, const size_t t0, const int lt0, const int gt0, const int rnd, const int emask) {
    int lanev = F.lane; asm volatile("" : "+v"(lanev));
    const int lane = lanev, lq = lane >> 4, ln = lane & 15;
    const LAS unsigned short* IDXS = (const LAS unsigned short*)(F.lds + P9_IDX) + lt0 * 128; const LAS unsigned* GU = (const LAS unsigned*)(F.lds + P9_GU) + gt0 * 128;
    LAS float* ZP = (LAS float*)(F.lds + P9_ZP) + gt0 * 128;
    LAS unsigned char* CQ = F.lds + P9_CQ + lt0 * 128; LAS float* CINV = (LAS float*)(F.lds + P9_CINV) + lt0;
    LAS unsigned char* hrow = F.lds + P9_HROW + F.wave * 512;
    const LAS unsigned char* habase = (lq == (ln >> 2) ? hrow + 16 * (ln & 3) : F.lds + P9_ZERO) + rnd * 256;
    const int dim0 = 16 * ln + 4 * lq;
    const int ucol = rnd * 256 + (lane & 3) * 16;
    const int zslot = 4 * lq + (ln >> 2);
    unsigned char* H4 = F.XN8; float* HS = (float*)(F.XN8 + (size_t)M * 512);
    v2u hw[4] = {{0u, 0u}, {0u, 0u}, {0u, 0u}, {0u, 0u}}; float sst = 0.f; v2u hqn = {0u, 0u}; float hsn = 0.f; p9v4i buf[4][4];
    {
#pragma unroll
        for (int b = 0; b < 4; ++b) { const int uo = ((int)IDXS[16 * b + (lane >> 2)] & P9_EM) * D + ucol;
#pragma unroll
            for (int s2 = 0; s2 < 4; ++s2) buf[b][s2] = *(const p9v4i*)(F.UT + (size_t)(unsigned)uo + s2 * 64);
        }
        if (rnd == 0) {
#pragma unroll
            for (int G = 0; G < 4; ++G) hw[G] = *(const v2u*)(F.X1 + t0 * D + 256 * G + dim0);
            sst = F.SS[t0 * 16 + ln]; }
        else { hqn = __builtin_nontemporal_load((const v2u*)(H4 + t0 * 512 + lane * 8)); hsn = HS[t0]; }
    }
#pragma unroll 1
    for (int it = 0; it < 8; ++it) {
        const int itn = it < 7 ? it + 1 : it;
        float hs;
        if (rnd != 0) { *(LAS v2u*)(hrow + lane * 8) = hqn; hs = hsn; }
        else
        {
            float s16 = sst;
            s16 = row16_sum(s16);
            const float rstd = 1.0f / sqrtf(s16 * (1.f / D) + RMS_EPS);
            float hf[16], sq = 0.f;
#pragma unroll
            for (int G = 0; G < 4; ++G) { const f32x4 g = *(const LAS f32x4*)(F.lds + P9_GV + (256 * G + dim0) * 4);
                hf[4 * G] = bflo(hw[G].x) * g.x * rstd; hf[4 * G + 1] = bfhi(hw[G].x) * g.y * rstd; hf[4 * G + 2] = bflo(hw[G].y) * g.z * rstd; hf[4 * G + 3] = bfhi(hw[G].y) * g.w * rstd;
                sq += (hf[4 * G] * hf[4 * G] + hf[4 * G + 1] * hf[4 * G + 1]) + (hf[4 * G + 2] * hf[4 * G + 2] + hf[4 * G + 3] * hf[4 * G + 3]); }
            const float hr = sqrtf(wave_sum_dpp(sq) * (1.f / D));
            const float qi = hr > 0.f ? 2.0f / hr : 0.f; hs = hr * 0.5f;
#pragma unroll
            for (int G = 0; G < 4; ++G) { unsigned p = 0u;
                p = __builtin_amdgcn_cvt_scalef32_pk_fp4_f32(p, hf[4 * G] * qi, hf[4 * G + 1] * qi, 1.0f, 0); p = __builtin_amdgcn_cvt_scalef32_pk_fp4_f32(p, hf[4 * G + 2] * qi, hf[4 * G + 3] * qi, 1.0f, 1);
                *(LAS unsigned short*)(hrow + 128 * G + (dim0 >> 1)) = (unsigned short)p; }
            *(v2u*)(H4 + (t0 + it) * 512 + lane * 8) = *(const LAS v2u*)(hrow + lane * 8); if (lane == 0) HS[t0 + it] = hs;
        }
        p9v4i hA[4];
#pragma unroll
        for (int s2 = 0; s2 < 4; ++s2) hA[s2] = *(const LAS p9v4i*)(habase + s2 * 64);
        float cval[8];
#pragma unroll
        for (int s = 0; s < 8; ++s) {
            const int bs = s & 3;
            {
                f32x4 zc = (f32x4){0.f, 0.f, 0.f, 0.f};
#pragma unroll
                for (int s2 = 0; s2 < 4; ++s2) {
                    const p9v8i tb = {buf[bs][s2].x, buf[bs][s2].y, buf[bs][s2].z, buf[bs][s2].w, 0, 0, 0, 0};
                    const p9v8i aa = {hA[s2].x, hA[s2].y, hA[s2].z, hA[s2].w, 0, 0, 0, 0};
                    zc = __builtin_amdgcn_mfma_scale_f32_16x16x128_f8f6f4(aa, tb, zc, 4, 4, 0, 0x7f7f7f7f, 0, 0x7f7f7f7f);
                }
                const int r = ln & 3; float zsel = r == 0 ? zc[0] : r == 1 ? zc[1] : r == 2 ? zc[2] : zc[3];
                zsel = quad_sum(zsel);
                if (rnd == 0) { if ((ln & 3) == 0) ZP[it * 128 + 16 * s + zslot] = zsel; cval[s] = 0.f; }
                else {
                    zsel += ZP[it * 128 + 16 * s + zslot];
                    const unsigned gu = GU[it * 128 + 16 * s + zslot];
                    const float usc = (float)__builtin_bit_cast(_Float16, (unsigned short)(gu & 0xffffu)), gv = (float)__builtin_bit_cast(_Float16, (unsigned short)(gu >> 16));
                    cval[s] = gelu_erf(zsel * hs * usc) * gv;
                }
            }
            { const int uo = ((int)IDXS[(s + 4 < 8 ? it : itn) * 128 + 16 * ((s + 4) & 7) + (lane >> 2)] & P9_EM) * D + ucol;
#pragma unroll
                for (int s2 = 0; s2 < 4; ++s2) buf[bs][s2] = *(const p9v4i*)(F.UT + (size_t)(unsigned)uo + s2 * 64);
            }
            if (s == 3) {
                if (rnd == 0) {
#pragma unroll
                    for (int G = 0; G < 4; ++G) hw[G] = *(const v2u*)(F.X1 + (t0 + itn) * D + 256 * G + dim0);
                    sst = F.SS[(t0 + itn) * 16 + ln]; }
                else { hqn = __builtin_nontemporal_load((const v2u*)(H4 + (t0 + itn) * 512 + lane * 8)); hsn = HS[t0 + itn]; }
            }
        }
        if (rnd != 0) {
            float cm = 0.f;
#pragma unroll
            for (int g = 0; g < 8; ++g) cm = fmaxf(cm, __builtin_fabsf(cval[g]));
            cm = wave_max_dpp(cm);
            const float cq = cm > 0.f ? 256.0f / cm : 0.f;
            v2u cw;
            { int p = __builtin_amdgcn_cvt_pk_fp8_f32(cval[0] * cq, cval[1] * cq, 0, false); p = __builtin_amdgcn_cvt_pk_fp8_f32(cval[2] * cq, cval[3] * cq, p, true); cw.x = (unsigned)p; }
            { int p = __builtin_amdgcn_cvt_pk_fp8_f32(cval[4] * cq, cval[5] * cq, 0, false); p = __builtin_amdgcn_cvt_pk_fp8_f32(cval[6] * cq, cval[7] * cq, p, true); cw.y = (unsigned)p; }
            if ((ln & 3) == 0) *(LAS v2u*)(CQ + it * 128 + (4 * lq + (ln >> 2)) * 8) = cw;
            if (lane == 0) CINV[it] = cm * (1.0f / 256.0f);
        }
    }
}
template <int NR  > __device__ __forceinline__ void p9_vsum8(Frame& F, const size_t t0, const int lt0, const int hf  , const int emask, const bool dummy) {
    constexpr int SPT = 8 / NR, NP = 4 / NR;
    int lanev = F.lane; asm volatile("" : "+v"(lanev));
    const int lane = lanev, lq = lane >> 4, ln = lane & 15;
    const LAS unsigned short* IDXS = (const LAS unsigned short*)(F.lds + P9_IDX) + lt0 * 128;
    const LAS unsigned char* CQ = F.lds + P9_CQ + lt0 * 128; const LAS float* CINV = (const LAS float*)(F.lds + P9_CINV) + lt0;
    LAS unsigned char* img = F.lds + P9_IMG + F.wave * P9_IMG_W;
    LAS unsigned char* wbase = img + (2 * (lane & 7)) * P9_IMG_BLK + (lane >> 3) * 8;
    LAS unsigned char* rbase = img + lane * 8;
    const int dim0 = 16 * ln + 4 * lq;
    const int vslot0 = 16 * ((lane >> 3) & 7);
    const int vcol = D / 2 + hf * (512 / NR) + (lane & 7) * 16;
    int scl[4];
#pragma unroll
    for (int m = 0; m < 4; ++m) scl[m] = (ln >> 2) == m ? (0x7f << (8 * (ln & 3))) : 0;
    p9v4i buf[2][8]; v2u hwc[4] = {{0u, 0u}, {0u, 0u}, {0u, 0u}, {0u, 0u}};
#pragma unroll
    for (int b = 0; b < 2; ++b) {
#pragma unroll
        for (int i = 0; i < 8; ++i) { const int vo = ((int)IDXS[vslot0 + 4 * (i >> 1) + 2 * b + (i & 1)] & P9_EM) * D + vcol;
            buf[b][i] = *(const p9v4i*)(F.UT + (size_t)(unsigned)vo); }
    }
#pragma unroll 1
    for (int it = 0; it < 8; ++it) {
        const int itn = it < 7 ? it + 1 : it; const size_t t = t0 + it;
        const p9v4i cb0 = *(const LAS p9v4i*)(CQ + it * 128 + 16 * lq), cb1 = *(const LAS p9v4i*)(CQ + it * 128 + 64 + 16 * lq);
        const p9v8i cb = {cb0.x, cb0.y, cb0.z, cb0.w, cb1.x, cb1.y, cb1.z, cb1.w};
        const float cinv = CINV[it];
        f32x4 acc[NP]; p9v2i trA[16];
#pragma unroll
        for (int G = 0; G < NP; ++G) acc[G] = (f32x4){0.f, 0.f, 0.f, 0.f};
#pragma unroll
        for (int s = 0; s < SPT; ++s) {
            const int bs = s & 1;
#pragma unroll
            for (int i = 0; i < 8; ++i) {
                *(LAS p9v2i*)(wbase + 64 * i) = (p9v2i){buf[bs][i].x, buf[bs][i].y};
                *(LAS p9v2i*)(wbase + P9_IMG_BLK + 64 * i) = (p9v2i){buf[bs][i].z, buf[bs][i].w};
            }
            { const int vs = (s + 2) % SPT, tk = s + 2 < SPT ? it : itn;
#pragma unroll
                for (int i = 0; i < 8; ++i) { const int vo = ((int)IDXS[tk * 128 + vslot0 + 4 * (i >> 1) + 2 * (vs & 1) + (i & 1)] & P9_EM) * D + vcol + (vs >> 1) * 128;
                    buf[bs][i] = *(const p9v4i*)(F.UT + (size_t)(unsigned)vo); }
            }
            if (s == 1) {
#pragma unroll
                for (int G = 0; G < 4; ++G) if (hf == NR - 1) hwc[G] = __builtin_nontemporal_load((const v2u*)(F.X1 + t * D + 256 * G + dim0)); else if (G / NP == hf) hwc[G] = *(const v2u*)(F.X1 + t * D + 256 * G + dim0);
            }
            const int Pl = s >> 1;
            if ((s & 1) == 0) {
#pragma unroll
                for (int bb = 0; bb < 16; ++bb) trA[bb] = __builtin_amdgcn_ds_read_tr4_b64_v2i32((LAS p9v2i*)(rbase + bb * P9_IMG_BLK));
            } else {
                p9v2i trB[16];
#pragma unroll
                for (int bb = 0; bb < 16; ++bb) trB[bb] = __builtin_amdgcn_ds_read_tr4_b64_v2i32((LAS p9v2i*)(rbase + bb * P9_IMG_BLK));
#define P9_VBLK(bb, OPS) { const p9v8i aa = {trA[bb].x, trA[bb].y, trB[bb].x, trB[bb].y, 0, 0, 0, 0}; \
                acc[Pl] = __builtin_amdgcn_mfma_scale_f32_16x16x128_f8f6f4(aa, cb, acc[Pl], 4, 0, 0, 0x7f7f7f7f, OPS, scl[(bb) >> 2]); }
                P9_VBLK(0, 0) P9_VBLK(1, 1) P9_VBLK(2, 2) P9_VBLK(3, 3) P9_VBLK(4, 0) P9_VBLK(5, 1) P9_VBLK(6, 2) P9_VBLK(7, 3)
                P9_VBLK(8, 0) P9_VBLK(9, 1) P9_VBLK(10, 2) P9_VBLK(11, 3) P9_VBLK(12, 0) P9_VBLK(13, 1) P9_VBLK(14, 2) P9_VBLK(15, 3)
#undef P9_VBLK
            }
        }
        f32x4 r[4];
#pragma unroll
        for (int G = 0; G < 4; ++G) r[G] = (f32x4){bflo(hwc[G].x), bfhi(hwc[G].x), bflo(hwc[G].y), bfhi(hwc[G].y)};
        if (hf < NR - 1) {
#pragma unroll
            for (int Pl = 0; Pl < NP; ++Pl) { f32x4 y;
                if (NP == 1) y = hf == 0 ? r[0] : hf == 1 ? r[1] : r[2]; else y = r[Pl];
#if DBG_OUT == 0
                y += acc[Pl] * cinv;
#endif
                v2u o; o.x = pk2(y.x, y.y); o.y = pk2(y.z, y.w); if (!dummy) *(v2u*)(F.X1 + t * D + 256 * (hf * NP + Pl) + dim0) = o; }
            continue;
        }
        float* orow = F.out + t * D;
        float ss = 0.f;
#pragma unroll
        for (int G = 0; G < 4; ++G) { const int off = 256 * G + dim0;
#if DBG_OUT == 0
            if (G >= 4 - NP) r[G] += acc[G - (4 - NP)] * cinv;
#endif
#if DBG_OUT == 1
            r[G] = *(const f32x4*)(F.x + t * D + off);
#endif
#if DBG_SAN
            r[G].x = (__builtin_fabsf(r[G].x) < 1e30f) ? r[G].x : 0.f; r[G].y = (__builtin_fabsf(r[G].y) < 1e30f) ? r[G].y : 0.f; r[G].z = (__builtin_fabsf(r[G].z) < 1e30f) ? r[G].z : 0.f; r[G].w = (__builtin_fabsf(r[G].w) < 1e30f) ? r[G].w : 0.f;
#endif
            ss += (r[G].x * r[G].x + r[G].y * r[G].y) + (r[G].z * r[G].z + r[G].w * r[G].w); }
        const float rstd = 1.f / sqrtf(wave_sum_dpp(ss) * (1.f / D) + RMS_EPS);
        if (dummy) { if (lane == 0) ((float*)((unsigned char*)F.SS + 4 * MiB))[t] = rstd; continue; }
#pragma unroll
        for (int G = 0; G < 4; ++G) { const int off = 256 * G + dim0; const f32x4 g = *(const LAS f32x4*)(F.lds + P9_GV + D * 4 + off * 4);
            __builtin_nontemporal_store(r[G] * rstd * g, (f32x4*)(orow + off)); }
    }
}
__device__ __forceinline__ void p9_phase(Frame& F, const int emask = 0x3fff, const bool dummy = false) {
    ((LAS f32x2*)(F.lds + P9_GV))[F.tid] = ((const f32x2*)F.rms_ffn_g)[F.tid]; ((LAS f32x2*)(F.lds + P9_GV + D * 4))[F.tid] = ((const f32x2*)F.rms_final_g)[F.tid];
    if (F.tid < 128) ((LAS unsigned*)(F.lds + P9_ZERO))[F.tid] = 0u;
    const int ntile = M / P9_TOK;
    for (int tile0 = F.vcu; tile0 < ntile; tile0 += 2 * F.G) {
        __syncthreads();
        for (int j = 0; j < 2; ++j) { const int tile = tile0 + j * F.G; if (tile >= ntile) break;
            p9_topk(F, (size_t)tile * P9_TOK, j * P9_TOK);
            __syncthreads();
            for (int rnd = 0; rnd < 2; ++rnd) p9_dots8(F, (size_t)tile * P9_TOK + F.wave * 8, j * P9_TOK + F.wave * 8, F.wave * 8, rnd, emask);
            __syncthreads();
        }
        for (int rnd = 0; rnd < P9_VR; ++rnd)
        for (int j = 0; j < 2; ++j) { const int tile = tile0 + j * F.G; if (tile >= ntile) break;
            p9_vsum8<P9_VR>(F, (size_t)tile * P9_TOK + F.wave * 8, j * P9_TOK + F.wave * 8, rnd, emask, dummy);
        }
    }
    __syncthreads();
}

struct Args { const float* in[18]; float* out; unsigned char* ws; int ph_lo, ph_hi; };
__global__ void __launch_bounds__(NWAVES * 64, 2) mk_fwd(Args args) {
    extern __shared__ __attribute__((aligned(16))) unsigned char lds[];
    Frame F;
    F.lds = (LAS unsigned char*)lds;
    F.MISC = (volatile LAS unsigned*)(F.lds + MISC_OFF);
    F.wave = __builtin_amdgcn_readfirstlane((int)threadIdx.x >> 6); F.lane = mk_lane(); F.tid = F.wave * 64 + F.lane;
    F.G = gridDim.x; { const int bx = blockIdx.x; F.vcu = (F.G % 8 == 0) ? (bx % 8) * (F.G / 8) + bx / 8 : bx; }
    unsigned char* ws = args.ws;
    F.ctl = (gu32*)(ws + WS_CTL);
    F.x = args.in[0]; F.rms_mix_g = args.in[1]; F.w_in = args.in[2]; F.ret_gn_g = args.in[3]; F.conv_dw_w = args.in[4]; F.conv_dw_b = args.in[5]; F.conv_ln_g = args.in[6]; F.conv_ln_b = args.in[7];
    F.w_ret_proj = args.in[8]; F.w_conv_proj = args.in[9]; F.b_conv_proj = args.in[10]; F.w_out = args.in[11]; F.rms_ffn_g = args.in[12]; F.w_query = args.in[13]; F.sub_keys = args.in[14];
    F.peer_u = args.in[15]; F.peer_v = args.in[16]; F.rms_final_g = args.in[17]; F.out = args.out;
    F.ROPE = (f32x2*)(ws + WS_ROPE); F.WinT = (bf16*)(ws + WS_WIN); F.WrT = (bf16*)(ws + WS_WR); F.WcT = (bf16*)(ws + WS_WC); F.WoT = (bf16*)(ws + WS_WO); F.WqT = (bf16*)(ws + WS_WQ);
    F.UT = ws + WS_UT; F.XN8 = ws + WS_XN8; F.WinT8 = ws + WS_WIN8; F.VT = ws + WS_VT; F.USC = (float*)(ws + WS_USC); F.VSC = (float*)(ws + WS_VSC); F.XN = (bf16*)(ws + WS_XN); F.PROJ = (bf16*)(ws + WS_PROJ); F.S = (bf16*)(ws + WS_S);
    F.RA = (bf16*)args.out; F.CB = (bf16*)args.out + (size_t)M * RW; F.VH = (bf16*)args.out + (size_t)2 * M * RW; F.GH = (bf16*)args.out + (size_t)3 * M * RW; F.QH = (bf16*)(ws + WS_QH); F.KH = (bf16*)(ws + WS_KH); F.GTA = (bf16*)(ws + WS_GTA); F.GTB = (bf16*)(ws + WS_GTB); F.SC = (unsigned short*)(ws + WS_SC); F.X1 = (bf16*)(ws + WS_X1); F.SS = (float*)(ws + WS_SS);
    for (int u = F.tid; u < (LDS_BYTES - LDSCTL_OFF) / 4; u += NWAVES * 64) ((LAS unsigned*)(F.lds + LDSCTL_OFF))[u] = 0u;
    __syncthreads();
    XcdBarrier bar; bar.bar = (unsigned*)(F.ctl + CW_BAR); bar.x = 0; bar.st = nullptr;
    if (!MK_PER_PHASE) bar = xcd_barrier_post((unsigned*)(F.ctl + CW_BAR), F.MISC + 8, F.wave);
    const int lo = args.ph_lo, hi = args.ph_hi;
#define IN(k) (lo <= (k) && (k) < hi)
#define SEAM(k) do { if (IN(k) && hi > (k) + 1) { xcd_barrier(bar); if (DBG_DOUBLE_BAR) xcd_barrier(bar); } } while (0)
#define NREP(k) ((((DBG_REPEAT) >> (k)) & 1) + 1)

    if (IN(0)) { for (int rep = 0; rep < NREP(0); ++rep) { p0_prologue(F); if (rep + 1 < NREP(0)) { VM_WAIT(); __syncthreads(); } } SEAM(0); }
    if (IN(1)) {
        for (int rep = 0; rep < NREP(1); ++rep) {
        if constexpr (P1_FP8) {
            { pg8::Gemm g{F.XN, F.WinT, M, P1_NB, D}; pg8::StaticOrder S; S.init(M, P1_NB, F.G, (int)blockIdx.x);
              pg8::EpiProj E{F.PROJ, F.QH, F.KH, F.VH, F.GH, F.GTA, F.GTB, 0};
              pg8::gemm_phase<pg8::EpiProj, pg8::StaticOrder, PG8_ALIGN, PG8_SP2>(F.lds + RING_OFF, g, S, E, F.wave); }
            { pg8::Gemm g{(const bf16*)F.XN8, (const bf16*)F.WinT8, M, NIN - P1_NB, D}; pg8::StaticOrder S; S.init(M, NIN - P1_NB, F.G, (int)blockIdx.x);
              pg8::EpiProj E{F.PROJ, F.QH, F.KH, F.VH, F.GH, F.GTA, F.GTB, P1_NB / 256};
              pg8::gemm_phase<pg8::EpiProj, pg8::StaticOrder, PG8_ALIGN, PG8_SP2, true, P1_SA, P1_SB>(F.lds + RING_OFF, g, S, E, F.wave); }
        } else {
        pg8::Gemm g{F.XN, F.WinT, M, NIN, D}; pg8::StaticOrder S; S.init(M, NIN, F.G, (int)blockIdx.x);
        pg8::EpiProj E{F.PROJ, F.QH, F.KH, F.VH, F.GH, F.GTA, F.GTB, 0};
        pg8::gemm_phase<pg8::EpiProj, pg8::StaticOrder, PG8_ALIGN, PG8_SP2>(F.lds + RING_OFF, g, S, E, F.wave); }
        VM_WAIT(); __syncthreads(); }
        SEAM(1);
    }
    if (IN(2)) { F.lane = mk_lane(); F.tid = F.wave * 64 + F.lane;
        constexpr int NS = BATCH * NCH * RH, NC = M / CV_TOK;
        for (int rep = 0; rep < NREP(2); ++rep) {
        CvRegs C; int cit = F.vcu; if (cit < NC) p2_conv_load(F, cit, C);
        { P2Regs R; int it = F.vcu; if (it < NS) p2_state_load(F, it, R);
          for (; it < NS; it += F.G) { p2_state_stage(F, it, R); LDS_BARRIER(); if (it + F.G < NS) p2_state_load(F, it + F.G, R); p2_state_compute(F, it); LDS_BARRIER(); } }
        for (; cit < NC; cit += F.G) { p2_conv_stage(F, C); p2_conv_compute(F, cit, cit + F.G < NC ? cit + F.G : -1, C); }
        }
        SEAM(2);
    }
    if (IN(3)) { F.lane = mk_lane(); F.tid = F.wave * 64 + F.lane;
        p3_scan(F);
        SEAM(3); }
    if (IN(4)) { F.lane = mk_lane(); F.tid = F.wave * 64 + F.lane;
        for (int rep = 0; rep < NREP(4); ++rep) {
          constexpr int NI = BATCH * NCH * RH;
          P4Regs R; int it = F.vcu; if (it < NI) p4_load(F, it, R);
          for (; it < NI; it += F.G) {
              p4_stage(F, it, R); v4u gcur[4];
#pragma unroll
              for (int i = 0; i < 4; ++i) gcur[i] = R.g[i];
              LDS_BARRIER();
              if (it + F.G < NI) p4_load(F, it + F.G, R);
              p4_compute(F, it, gcur);
          }
        }
        SEAM(4);
    }
    if (IN(5)) { F.lane = mk_lane(); F.tid = F.wave * 64 + F.lane;
#if DBG_PROBE
        dbg_probe(F, 1);
#endif
        for (int rep = 0; rep < NREP(5); ++rep) {
          pg8::Gemm g{F.CB, F.WcT, M, D, CCH, F.RA, F.WrT}; pg8::DualOrder S; S.init(M, D, F.G, (int)blockIdx.x);
          pg8::EpiGateChain E{F.XN, D, F.GTA, F.GTB, F.b_conv_proj};
          pg8::gemm_phase<pg8::EpiGateChain, pg8::DualOrder, PG8_ALIGN, PG8_SP2>(F.lds + RING_OFF, g, S, E, F.wave); VM_WAIT(); __syncthreads(); }
        SEAM(5);
    }
    if (IN(6)) { F.lane = mk_lane(); F.tid = F.wave * 64 + F.lane;
        for (int rep = 0; rep < NREP(6); ++rep) {
        pg8::Gemm g{F.XN, F.WoT, M, D, D}; pg8::StaticOrder S; S.init(M, D, F.G, (int)blockIdx.x);
        pg8::EpiResBf16SS E{F.X1, D, F.x, F.SS};
        pg8::gemm_phase<pg8::EpiResBf16SS, pg8::StaticOrder, PG8_ALIGN, PG8_SP2, P6_FP8, P6_SA, P6_SB>(F.lds + RING_OFF, g, S, E, F.wave);
        VM_WAIT(); __syncthreads(); }
        SEAM(6);
    }
    if (IN(8)) { F.lane = mk_lane(); F.tid = F.wave * 64 + F.lane;
        for (int rep = 0; rep < NREP(8); ++rep) {
        pg8::Gemm g{F.X1, F.WqT, M, NSC, D}; pg8::StaticOrder S; S.init(M, NSC, F.G, (int)blockIdx.x);
        pg8::EpiF16Rstd E{F.SC, M / 8, F.SS, 1.0f / D, RMS_EPS};
        pg8::gemm_phase<pg8::EpiF16Rstd, pg8::StaticOrder, PG8_ALIGN, PG8_SP2>(F.lds + RING_OFF, g, S, E, F.wave);
        VM_WAIT(); __syncthreads(); }
        SEAM(8);
    }
    if (IN(9)) { F.lane = mk_lane(); F.tid = F.wave * 64 + F.lane;
#if DBG_DUMMY_EMASK
        p9_phase(F, DBG_DUMMY_EMASK, true);
#endif
        for (int rep = 0; rep < NREP(9); ++rep) p9_phase(F);
    }
#undef IN
#undef SEAM
}

extern "C" void kernel_launch(void* const* d_in, const int* in_sizes, int n_in, void* d_out, int out_size, void* d_ws, size_t ws_size, hipStream_t stream) {
    static int grid = 0;
    if (grid == 0) {
        if (n_in != 18 || in_sizes[0] != M * D || out_size != M * D || ws_size < WS_END) { fprintf(stderr, "kernel_launch: unexpected problem shape (n_in %d, in0 %d, out %d, ws %zu); nothing launched\n", n_in, n_in > 0 ? in_sizes[0] : -1, out_size, ws_size); grid = -1; return; }
        int dev = 0, cus = 0, per_cu = 0;
        if (hipGetDevice(&dev) != hipSuccess || hipDeviceGetAttribute(&cus, hipDeviceAttributeMultiprocessorCount, dev) != hipSuccess) { fprintf(stderr, "kernel_launch: device query failed\n"); grid = -1; return; }
        if (hipFuncSetAttribute((const void*)mk_fwd, hipFuncAttributeMaxDynamicSharedMemorySize, LDS_BYTES) != hipSuccess) { fprintf(stderr, "kernel_launch: hipFuncSetAttribute failed\n"); grid = -1; return; }
        if (hipOccupancyMaxActiveBlocksPerMultiprocessor(&per_cu, (const void*)mk_fwd, NWAVES * 64, LDS_BYTES) != hipSuccess || per_cu < 1) { fprintf(stderr, "kernel_launch: occupancy query reports %d workgroups per CU\n", per_cu); (void)hipGetLastError(); grid = -1; return; }
        grid = cus;
    }
    if (grid < 0) return;
    (void)hipMemsetAsync((char*)d_ws + WS_CTL, 0, CTL_ZERO_BYTES, stream);
    Args a{};
    for (int i = 0; i < 18; ++i) a.in[i] = (const float*)d_in[i];
    a.out = (float*)d_out; a.ws = (unsigned char*)d_ws;
#if MK_PER_PHASE
    for (int p = 0; p < N_PHASES; ++p) { if (!((DBG_PHASE_MASK >> p) & 1)) continue; a.ph_lo = p; a.ph_hi = p + 1; hipLaunchKernelGGL(mk_fwd, dim3(grid), dim3(NWAVES * 64), LDS_BYTES, stream, a); }
#else
    a.ph_lo = 0; a.ph_hi = N_PHASES;
    hipLaunchKernelGGL(mk_fwd, dim3(grid), dim3(NWAVES * 64), LDS_BYTES, stream, a);
#endif
    const hipError_t le = hipPeekAtLastError();
    if (le != hipSuccess) fprintf(stderr, "kernel_launch: launch failed: %s\n", hipGetErrorName(le));
}
```
